# Optimizing an MI355X kernel written in HIP

```python
import math
import jax, jax.numpy as jnp
from jax import lax
import numpy as np

D_MODEL = 1024
BATCH = 8
SEQ = 4096
DEPTH = 2

POOL_WINDOWS = (2, 4, 8, 16)
POOL_GROUP = D_MODEL // 8
POOL_WIDTH = POOL_GROUP * len(POOL_WINDOWS)
N_HEADS = 8
HEAD_DIM = 64
ATTN_WIDTH = N_HEADS * HEAD_DIM
KV_LATENT = 128
IDX_HEADS = 8
IDX_DIM = 64
TOPK_MAX = 256
Q_BLOCK = 128
D_FF = 4 * D_MODEL
NUM_BUCKETS = 32
MAX_DISTANCE = 128
MAX_EXACT = NUM_BUCKETS // 2
ALPHA = (2 * DEPTH) ** 0.25
BETA = (8 * DEPTH) ** -0.25
LN_EPS = 1e-5

MIX_WIDTH = POOL_WIDTH + ATTN_WIDTH
SPLIT_SIZES = (POOL_WIDTH, ATTN_WIDTH, KV_LATENT, IDX_HEADS * IDX_DIM, IDX_DIM, IDX_HEADS)
D_IN = sum(SPLIT_SIZES)
SPLIT_POINTS = tuple(int(v) for v in np.cumsum(SPLIT_SIZES)[:-1])

kernel_name = "hymba_pool_dsa_deepnorm_trunk"


def layer_norm(x, g, b):
    xf = x.astype(jnp.float32)
    mu = jnp.mean(xf, axis=-1, keepdims=True)
    var = jnp.mean(jnp.square(xf - mu), axis=-1, keepdims=True)
    return ((xf - mu) * lax.rsqrt(var + LN_EPS) * g + b).astype(x.dtype)


def rms_norm(x, g):
    xf = x.astype(jnp.float32)
    return (xf * lax.rsqrt(jnp.mean(jnp.square(xf), axis=-1, keepdims=True) + LN_EPS) * g).astype(x.dtype)


def t5_causal_bucket(n):
    nf = jnp.maximum(n, 1).astype(jnp.float32)
    large = MAX_EXACT + (jnp.log(nf / MAX_EXACT) / math.log(MAX_DISTANCE / MAX_EXACT)
                         * (NUM_BUCKETS - MAX_EXACT)).astype(jnp.int32)
    large = jnp.minimum(large, NUM_BUCKETS - 1)
    return jnp.where(n < MAX_EXACT, n, large)


def causal_multiscale_pool(u):
    B, S, _ = u.shape
    uf = u.astype(jnp.float32).reshape(B, S, len(POOL_WINDOWS), POOL_GROUP)
    cs = jnp.concatenate([jnp.zeros_like(uf[:, :1]), jnp.cumsum(uf, axis=1)], axis=1)
    hi = cs[:, 1:]
    t = jnp.arange(S)
    outs = []
    for g, w in enumerate(POOL_WINDOWS):
        lo = jnp.pad(cs[:, :S + 1 - w, g], ((0, 0), (w - 1, 0), (0, 0)))
        cnt = jnp.minimum(t + 1, w).astype(jnp.float32)[None, :, None]
        outs.append((hi[:, :, g] - lo) / cnt - uf[:, :, g])
    return jnp.stack(outs, axis=2).astype(u.dtype)


def dsa_sparse_attention(q_lat, latent, iq, ik, iw, rel_bias):
    B, S = latent.shape[:2]
    k_sel = min(TOPK_MAX, S // 4)
    nb = S // Q_BLOCK
    key_pos = jnp.arange(S)

    def to_blocks(a):
        return jnp.moveaxis(a.reshape(B, nb, Q_BLOCK, *a.shape[2:]), 1, 0)

    def one_block(args):
        blk, qb, iqb, iwb = args
        q_pos = blk * Q_BLOCK + jnp.arange(Q_BLOCK)
        dots = jnp.einsum('bqhd,bsd->bqhs', iqb, ik).astype(jnp.float32) * IDX_DIM ** -0.5
        score = jnp.einsum('bqh,bqhs->bqs', iwb.astype(jnp.float32), jax.nn.relu(dots))
        causal = key_pos[None, :] <= q_pos[:, None]
        score = jnp.where(causal[None], score, -jnp.inf)
        _, idx = lax.top_k(score, k_sel)
        valid = idx <= q_pos[None, :, None]
        c_sel = jax.vmap(lambda c, i: c[i])(latent, idx)
        logits = jnp.einsum('bqhc,bqkc->bqhk', qb, c_sel).astype(jnp.float32) * HEAD_DIM ** -0.5
        bucket = t5_causal_bucket(jnp.maximum(q_pos[None, :, None] - idx, 0))
        bias = jnp.moveaxis(rel_bias[bucket].astype(jnp.float32), -1, 2)
        logits = jnp.where(valid[:, :, None, :], logits + bias, -jnp.inf)
        p = jax.nn.softmax(logits, axis=-1).astype(c_sel.dtype)
        return jnp.einsum('bqhk,bqkc->bqhc', p, c_sel)

    out = lax.map(one_block, (jnp.arange(nb), to_blocks(q_lat), to_blocks(iq), to_blocks(iw)))
    return jnp.moveaxis(out, 0, 1).reshape(B, S, N_HEADS, KV_LATENT)


def setup_inputs(seed: int = 0) -> dict:
    key = jax.random.key(seed)
    ks = jax.random.split(key, 20)

    def nrm(k, shape, scale):
        return jax.random.normal(k, shape, jnp.float32) * scale

    L = DEPTH
    return {
        "x": nrm(ks[0], (BATCH, SEQ, D_MODEL), 1.0),
        "emb_ln_g": 1.0 + nrm(ks[1], (D_MODEL,), 0.02),
        "emb_ln_b": nrm(ks[2], (D_MODEL,), 0.02),
        "rel_bias": nrm(ks[3], (NUM_BUCKETS, N_HEADS), 0.5),
        "w_in": nrm(ks[4], (L, D_MODEL, D_IN), D_MODEL ** -0.5),
        "pool_w": nrm(ks[5], (L, len(POOL_WINDOWS), POOL_GROUP, POOL_GROUP), POOL_GROUP ** -0.5),
        "pool_scale": 1.0 + nrm(ks[6], (L, POOL_WIDTH), 0.02),
        "kv_norm_g": 1.0 + nrm(ks[7], (L, KV_LATENT), 0.02),
        "w_uk": nrm(ks[8], (L, KV_LATENT, N_HEADS, HEAD_DIM), KV_LATENT ** -0.5),
        "w_uv": nrm(ks[9], (L, KV_LATENT, N_HEADS, HEAD_DIM), KV_LATENT ** -0.5 * BETA),
        "w_o": nrm(ks[10], (L, MIX_WIDTH, D_MODEL), MIX_WIDTH ** -0.5 * BETA),
        "ln1_g": 1.0 + nrm(ks[11], (L, D_MODEL), 0.02),
        "ln1_b": nrm(ks[12], (L, D_MODEL), 0.02),
        "w_up": nrm(ks[13], (L, D_MODEL, D_FF), D_MODEL ** -0.5),
        "w_down": nrm(ks[14], (L, D_FF, D_MODEL), D_FF ** -0.5 * BETA),
        "ln2_g": 1.0 + nrm(ks[15], (L, D_MODEL), 0.02),
        "ln2_b": nrm(ks[16], (L, D_MODEL), 0.02),
    }


def reference(x, emb_ln_g, emb_ln_b, rel_bias, w_in, pool_w, pool_scale, kv_norm_g,
              w_uk, w_uv, w_o, ln1_g, ln1_b, w_up, w_down, ln2_g, ln2_b):
    B, S, _ = x.shape
    x = layer_norm(x, emb_ln_g, emb_ln_b)
    for l in range(DEPTH):
        proj = x @ w_in[l]
        u_pool, q, c, iq, ik, iw = jnp.split(proj, SPLIT_POINTS, axis=-1)
        pooled = causal_multiscale_pool(u_pool)
        pool_out = jnp.einsum('bsgc,gcd->bsgd', pooled, pool_w[l]).reshape(B, S, POOL_WIDTH) * pool_scale[l]
        q = q.reshape(B, S, N_HEADS, HEAD_DIM)
        q_lat = jnp.einsum('bshd,chd->bshc', q, w_uk[l])
        c = rms_norm(c, kv_norm_g[l])
        iq = iq.reshape(B, S, IDX_HEADS, IDX_DIM)
        iw = iw * IDX_HEADS ** -0.5
        o_lat = dsa_sparse_attention(q_lat, c, iq, ik, iw, rel_bias)
        attn_out = jnp.einsum('bshc,chd->bshd', o_lat, w_uv[l]).reshape(B, S, ATTN_WIDTH)
        mix = jnp.concatenate([pool_out, attn_out], axis=-1) @ w_o[l]
        x = layer_norm(ALPHA * x + mix, ln1_g[l], ln1_b[l])
        ff = jnp.square(jax.nn.relu(x @ w_up[l])) @ w_down[l]
        x = layer_norm(ALPHA * x + ff, ln2_g[l], ln2_b[l])
    return x
```

```cpp
#define MK_PER_PHASE 1
#include <hip/hip_runtime.h>
#include <cstdio>
#include <cstdint>
namespace pg8 {
#define PG8_LAS __attribute__((address_space(3)))
typedef unsigned short bf16_t;
typedef short bf16x8 __attribute__((ext_vector_type(8)));
typedef float f32x4 __attribute__((ext_vector_type(4)));
typedef unsigned u32x4 __attribute__((ext_vector_type(4)));
constexpr int BM = 256, BK = 64, HALF = 128, HTB = HALF * BK * 2  , STAGE_BYTES = 8 * HTB, NXCD = 8, WGM = 8;

__host__ __device__ __forceinline__ int lds_byte(int r, int c) { const int st = (r >> 4) * 2 + (c >> 5), rr = r & 15, cc = c & 31, ob = rr * 64 + cc * 2; return st * 1024 + (ob ^ (((ob >> 9) & 1) << 5)); }
__host__ __device__ __forceinline__ void stage_rc(int b, int& R, int& C) { const int st = b / 1024, sb = b % 1024, swz = sb ^ (((sb >> 9) & 1) << 5); R = (st >> 1) * 16 + swz / 64; C = (st & 1) * 32 + (swz % 64) / 2; }
__host__ __device__ __forceinline__ int perm32(int rho) { const int n = rho >> 4, i = rho & 15; return 8 * (i >> 2) + 4 * n + (i & 3); }

struct Unit { int pm, pn; };
struct Gemm { const bf16_t* A; const bf16_t* Bt; int M, N, K; };

struct StaticOrder {
    int nM, nN, nwg, G, c;
    __host__ __device__ void init(int M, int N, int G_, int c_) { nM = M / BM; nN = N / BM; nwg = nM * nN; G = G_; c = c_; }
    __host__ __device__ bool next(int i, Unit& u) const {
        const long L = (long)i * G + c; if (L >= nwg) return false;
        int wgid = (int)L; { const int q = nwg / NXCD, r = nwg % NXCD, xcd = wgid % NXCD, off = wgid / NXCD; wgid = (xcd < r ? xcd * (q + 1) : r * (q + 1) + (xcd - r) * q) + off; }
        const int nig = WGM * nN, gid = wgid / nig, fm = gid * WGM, gsz = (nM - fm) < WGM ? (nM - fm) : WGM;
        u.pm = fm + ((wgid % nig) % gsz); u.pn = (wgid % nig) / gsz; return true;
    }
    __device__ __forceinline__ void a_ready(const Unit&) const {}
    __device__ __forceinline__ void done(const Unit&) const {}
};

__device__ __forceinline__ unsigned cvt_pk_bf16(float lo, float hi) { unsigned r; asm volatile("v_cvt_pk_bf16_f32 %0, %1, %2" : "=v"(r) : "v"(lo), "v"(hi)); return r; }

struct EpiProj {
    static constexpr bool PERM = true, AFTER_DRAIN = false;
    bf16_t* O; int ldc; float* ss;
    __device__ __forceinline__ void operator()(const f32x4 (&acc)[2][2][4][2], const Unit& u, int wr, int wc, int fr, int fq) const {
        const int row0 = u.pm * BM + wr * 64 + fr, col0 = u.pn * BM + wc * 32 + 8 * fq;
#pragma unroll
        for (int ai = 0; ai < 2; ++ai)
#pragma unroll
            for (int m = 0; m < 4; ++m) { bf16_t* rowp = O + (size_t)(row0 + ai * HALF + m * 16) * ldc + col0;
#pragma unroll
                for (int bj = 0; bj < 2; ++bj) { const f32x4 v0 = acc[ai][bj][m][0], v1 = acc[ai][bj][m][1];
                    u32x4 w; w.x = cvt_pk_bf16(v0[0], v0[1]); w.y = cvt_pk_bf16(v0[2], v0[3]); w.z = cvt_pk_bf16(v1[0], v1[1]); w.w = cvt_pk_bf16(v1[2], v1[3]);
                    *(u32x4*)(rowp + bj * HALF) = w; } }
        if (u.pn == 4) {
#pragma unroll
            for (int ai = 0; ai < 2; ++ai)
#pragma unroll
                for (int m = 0; m < 4; ++m) { const f32x4 v0 = acc[ai][0][m][0], v1 = acc[ai][0][m][1];
                    float s = (v0[0] * v0[0] + v0[1] * v0[1]) + (v0[2] * v0[2] + v0[3] * v0[3]) + (v1[0] * v1[0] + v1[1] * v1[1]) + (v1[2] * v1[2] + v1[3] * v1[3]);
                    s += __shfl_xor(s, 16); s += __shfl_xor(s, 32);
                    if (fq == 0) atomicAdd(ss + (row0 + ai * HALF + m * 16), s); }
        }
    }
};
struct EpiRes {
    static constexpr bool PERM = false, AFTER_DRAIN = false;
    float* X; int ldc; float alpha;
    __device__ __forceinline__ void operator()(const f32x4 (&acc)[2][2][4][2], const Unit& u, int wr, int wc, int fr, int fq) const {
        const int row0 = u.pm * BM + wr * 64 + fr, col0 = u.pn * BM + wc * 32 + 4 * fq;
#pragma unroll
        for (int ai = 0; ai < 2; ++ai)
#pragma unroll
            for (int m = 0; m < 4; ++m) { float* rowp = X + (size_t)(row0 + ai * HALF + m * 16) * ldc + col0;
#pragma unroll
                for (int bj = 0; bj < 2; ++bj)
#pragma unroll
                    for (int n = 0; n < 2; ++n) { float* q = rowp + bj * HALF + n * 16; const f32x4 v = *(const f32x4*)q; *(f32x4*)q = v * alpha + acc[ai][bj][m][n]; }
                asm volatile("" ::: "memory"); }
    }
};
struct EpiRelu2 {
    static constexpr bool PERM = true, AFTER_DRAIN = false;
    bf16_t* O; int ldc;
    __device__ __forceinline__ void operator()(const f32x4 (&acc)[2][2][4][2], const Unit& u, int wr, int wc, int fr, int fq) const {
        const int row0 = u.pm * BM + wr * 64 + fr, col0 = u.pn * BM + wc * 32 + 8 * fq;
#pragma unroll
        for (int ai = 0; ai < 2; ++ai)
#pragma unroll
            for (int m = 0; m < 4; ++m) { bf16_t* rowp = O + (size_t)(row0 + ai * HALF + m * 16) * ldc + col0;
#pragma unroll
                for (int bj = 0; bj < 2; ++bj) { f32x4 v0 = acc[ai][bj][m][0], v1 = acc[ai][bj][m][1];
#pragma unroll
                    for (int j = 0; j < 4; ++j) { const float a = fmaxf(v0[j], 0.f), b = fmaxf(v1[j], 0.f); v0[j] = a * a; v1[j] = b * b; }
                    u32x4 w; w.x = cvt_pk_bf16(v0[0], v0[1]); w.y = cvt_pk_bf16(v0[2], v0[3]); w.z = cvt_pk_bf16(v1[0], v1[1]); w.w = cvt_pk_bf16(v1[2], v1[3]);
                    *(u32x4*)(rowp + bj * HALF) = w; } }
    }
};

template <class Epi, class Sched, bool ALIGN_EPI = false, bool SP2 = false>
__device__ __forceinline__ void gemm_phase(PG8_LAS unsigned char* lds, const Gemm g, const Sched& S, const Epi& E) {
    const int tid = threadIdx.x, wid = __builtin_amdgcn_readfirstlane(tid >> 6), lane = tid & 63, wr = wid >> 2, wc = wid & 3, fr = lane & 15, fq = lane >> 4;
    const int K = g.K, nt = K / BK;
    unsigned voffA[2], voffB[2];
#pragma unroll
    for (int i = 0; i < 2; ++i) { int R, C; stage_rc(tid * 16 + i * 8192, R, C); const int Rb = Epi::PERM ? ((R & ~31) + perm32(R & 31)) : R;
        voffA[i] = (unsigned)(R * K + C) * 2u; voffB[i] = (unsigned)(Rb * K + C) * 2u; }
    const size_t kstep = (size_t)(BK * 2);
    const size_t hstep = (size_t)HALF * K * 2;
    const size_t tstep = 2 * hstep;
    const unsigned ldsw = (unsigned)wid * 1024u;
    const int aoff = lds_byte(wr * 64 + fr, fq * 8), boff = lds_byte(wc * 32 + fr, fq * 8);
#define PG8_SA(b, h) (((b) * 2 + (h)) * HTB)
#define PG8_SB(b, h) ((4 + (b) * 2 + (h)) * HTB)
#define PG8_STAGE(bufoff, gbase, voff) do { _Pragma("unroll") for (int _i = 0; _i < 2; ++_i) \
        __builtin_amdgcn_global_load_lds((const unsigned*)((const char*)(gbase) + (voff)[_i]), (PG8_LAS unsigned*)(lds + (bufoff) + ldsw + _i * 8192), 16, 0, 0); } while (0)
#define PG8_LDA(dst, b, h) do { _Pragma("unroll") for (int m = 0; m < 4; ++m) _Pragma("unroll") for (int k = 0; k < 2; ++k) dst[m][k] = *(const PG8_LAS bf16x8*)(lds + PG8_SA(b, h) + aoff + m * 2048 + k * 1024); } while (0)
#define PG8_LDB(dst, b, h) do { _Pragma("unroll") for (int n = 0; n < 2; ++n) _Pragma("unroll") for (int k = 0; k < 2; ++k) dst[n][k] = *(const PG8_LAS bf16x8*)(lds + PG8_SB(b, h) + boff + n * 2048 + k * 1024); } while (0)
#define PG8_MMA(ai, bj, At, Bt) do { __builtin_amdgcn_s_setprio(1); _Pragma("unroll") for (int m = 0; m < 4; ++m) _Pragma("unroll") for (int n = 0; n < 2; ++n) _Pragma("unroll") for (int k = 0; k < 2; ++k) \
        acc[ai][bj][m][n] = __builtin_amdgcn_mfma_f32_16x16x32_bf16(Bt[n][k], At[m][k], acc[ai][bj][m][n], 0, 0, 0); __builtin_amdgcn_s_setprio(0); } while (0)
#define PG8_WAIT_V(n) asm volatile("s_waitcnt vmcnt(" #n ")" ::: "memory")
#define PG8_WAIT_L(n) asm volatile("s_waitcnt lgkmcnt(" #n ")" ::: "memory")
#define PG8_BAR __builtin_amdgcn_s_barrier()
#define PG8_SCHED __builtin_amdgcn_sched_barrier(0)
    Unit cur, nxt; int ui = 0;
    if (!S.next(0, cur)) return;
    f32x4 acc[2][2][4][2];
#pragma unroll
    for (int a = 0; a < 2; ++a)
#pragma unroll
        for (int b = 0; b < 2; ++b)
#pragma unroll
            for (int m = 0; m < 4; ++m)
#pragma unroll
                for (int n = 0; n < 2; ++n) acc[a][b][m][n] = (f32x4){0.f, 0.f, 0.f, 0.f};
    bf16x8 At[4][2], B0[2][2], B1[2][2];
    const char* cA = (const char*)g.A + (size_t)cur.pm * tstep; const char* cB = (const char*)g.Bt + (size_t)cur.pn * tstep;
    S.a_ready(cur);
    if constexpr (SP2) {
        PG8_STAGE(PG8_SB(0, 0), cB, voffB); PG8_STAGE(PG8_SB(0, 1), cB + hstep, voffB); PG8_STAGE(PG8_SA(0, 0), cA, voffA); PG8_STAGE(PG8_SA(0, 1), cA + hstep, voffA);
        if (wr == 1) PG8_BAR;
        PG8_WAIT_V(2); PG8_BAR;
        PG8_STAGE(PG8_SB(1, 0), cB + kstep, voffB); PG8_STAGE(PG8_SA(1, 0), cA + kstep, voffA); PG8_STAGE(PG8_SB(1, 1), cB + hstep + kstep, voffB);
        PG8_WAIT_V(6); PG8_BAR;
    } else {
        PG8_STAGE(PG8_SB(0, 0), cB, voffB); PG8_STAGE(PG8_SA(0, 0), cA, voffA); PG8_STAGE(PG8_SB(0, 1), cB + hstep, voffB); PG8_STAGE(PG8_SA(0, 1), cA + hstep, voffA);
        if (wr == 1) PG8_BAR;
        PG8_WAIT_V(4); PG8_BAR;
        PG8_STAGE(PG8_SB(1, 0), cB + kstep, voffB); PG8_STAGE(PG8_SA(1, 0), cA + kstep, voffA); PG8_STAGE(PG8_SB(1, 1), cB + hstep + kstep, voffB);
        PG8_WAIT_V(6); PG8_BAR;
    }
    for (;;) {
        const bool has_next = S.next(ui + 1, nxt);
        const char* nA = has_next ? (const char*)g.A + (size_t)nxt.pm * tstep : cA; const char* nB = has_next ? (const char*)g.Bt + (size_t)nxt.pn * tstep : cB;
        for (int t = 0; t < nt; t += 2) {
            const bool last = (t == nt - 2);
            const char* a1 = cA + (size_t)(t + 1) * kstep;
            const char* a2 = last ? nA : cA + (size_t)(t + 2) * kstep; const char* b2 = last ? nB : cB + (size_t)(t + 2) * kstep;
            const char* a3 = a2 + kstep; const char* b3 = b2 + kstep;
            if (last && has_next) S.a_ready(nxt);
            if constexpr (SP2) {
            PG8_LDB(B0, 0, 0); PG8_LDB(B1, 0, 1); PG8_SCHED; PG8_LDA(At, 0, 0); PG8_STAGE(PG8_SA(1, 1), a1 + hstep, voffA);
            PG8_WAIT_V(8); PG8_WAIT_L(0); PG8_BAR; PG8_MMA(0, 0, At, B0); PG8_MMA(0, 1, At, B1); PG8_BAR; PG8_SCHED;
            PG8_LDA(At, 0, 1); PG8_STAGE(PG8_SB(0, 0), b2, voffB); PG8_STAGE(PG8_SB(0, 1), b2 + hstep, voffB); PG8_STAGE(PG8_SA(0, 0), a2, voffA);
            PG8_WAIT_V(8); PG8_WAIT_L(0); PG8_BAR; PG8_MMA(1, 0, At, B0); PG8_MMA(1, 1, At, B1); PG8_BAR; PG8_SCHED;
            PG8_LDB(B0, 1, 0); PG8_LDB(B1, 1, 1); PG8_SCHED; PG8_LDA(At, 1, 0); PG8_STAGE(PG8_SA(0, 1), a2 + hstep, voffA);
            PG8_WAIT_V(8); PG8_WAIT_L(0); PG8_BAR; PG8_MMA(0, 0, At, B0); PG8_MMA(0, 1, At, B1); PG8_BAR; PG8_SCHED;
            PG8_LDA(At, 1, 1); PG8_STAGE(PG8_SB(1, 0), b3, voffB); PG8_STAGE(PG8_SB(1, 1), b3 + hstep, voffB); PG8_STAGE(PG8_SA(1, 0), a3, voffA);
            PG8_WAIT_V(8); PG8_WAIT_L(0); PG8_BAR; PG8_MMA(1, 0, At, B0); PG8_MMA(1, 1, At, B1); PG8_BAR; PG8_SCHED;
            } else {
            PG8_LDB(B0, 0, 0); PG8_SCHED; PG8_LDA(At, 0, 0); PG8_STAGE(PG8_SA(1, 1), a1 + hstep, voffA);
            PG8_WAIT_L(8); PG8_BAR; PG8_WAIT_L(0); PG8_MMA(0, 0, At, B0); PG8_BAR; PG8_SCHED;
            PG8_LDB(B1, 0, 1); PG8_STAGE(PG8_SB(0, 0), b2, voffB);
            PG8_BAR; PG8_WAIT_L(0); PG8_MMA(0, 1, At, B1); PG8_BAR;
            PG8_LDA(At, 0, 1); PG8_STAGE(PG8_SA(0, 0), a2, voffA);
            PG8_BAR; PG8_WAIT_L(0); PG8_MMA(1, 0, At, B0); PG8_BAR; PG8_SCHED;
            PG8_STAGE(PG8_SB(0, 1), b2 + hstep, voffB);
            PG8_WAIT_V(6); PG8_BAR; PG8_MMA(1, 1, At, B1); PG8_BAR;
            PG8_LDB(B0, 1, 0); PG8_SCHED; PG8_LDA(At, 1, 0); PG8_STAGE(PG8_SA(0, 1), a2 + hstep, voffA);
            PG8_WAIT_L(8); PG8_BAR; PG8_WAIT_L(0); PG8_MMA(0, 0, At, B0); PG8_BAR; PG8_SCHED;
            PG8_LDB(B1, 1, 1); PG8_STAGE(PG8_SB(1, 0), b3, voffB);
            PG8_BAR; PG8_WAIT_L(0); PG8_MMA(0, 1, At, B1); PG8_BAR;
            PG8_LDA(At, 1, 1); PG8_STAGE(PG8_SA(1, 0), a3, voffA);
            PG8_BAR; PG8_WAIT_L(0); PG8_MMA(1, 0, At, B0); PG8_BAR; PG8_SCHED;
            PG8_STAGE(PG8_SB(1, 1), b3 + hstep, voffB);
            PG8_WAIT_V(6); PG8_BAR; PG8_MMA(1, 1, At, B1); PG8_BAR;
            }
        }
        if constexpr (ALIGN_EPI) { if (wr == 0) PG8_BAR; }
        if constexpr (!Epi::AFTER_DRAIN) { E(acc, cur, wr, wc, fr, fq); S.done(cur); }
        if (!has_next) break;
#pragma unroll
        for (int a = 0; a < 2; ++a)
#pragma unroll
            for (int b = 0; b < 2; ++b)
#pragma unroll
                for (int m = 0; m < 4; ++m)
#pragma unroll
                    for (int n = 0; n < 2; ++n) acc[a][b][m][n] = (f32x4){0.f, 0.f, 0.f, 0.f};
        cur = nxt; cA = nA; cB = nB; ++ui;
        if constexpr (ALIGN_EPI) { if (wr == 1) PG8_BAR; }
    }
    PG8_WAIT_V(0);
    if constexpr (!ALIGN_EPI) { if (wr == 0) PG8_BAR; }
    PG8_BAR;
    if constexpr (Epi::AFTER_DRAIN) { E.fused(acc, cur, wr, wc, fr, fq, lds, wid, lane); S.done(cur); }
#undef PG8_SA
#undef PG8_SB
#undef PG8_STAGE
#undef PG8_LDA
#undef PG8_LDB
#undef PG8_MMA
#undef PG8_WAIT_V
#undef PG8_WAIT_L
#undef PG8_BAR
#undef PG8_SCHED
}
}
#ifndef PG8_SP2
#define PG8_SP2 true
#endif
#ifndef PG8_ALIGN
#define PG8_ALIGN true
#endif
constexpr int NWAVES = 8;
#ifndef MK_PER_PHASE
#define MK_PER_PHASE 0
#endif

constexpr int BATCH = 8, SEQ = 4096, D = 1024, M = BATCH * SEQ, DIN = 1736, NP = 1792, FF = 4096, KO = 1536, NLAYER = 2;
constexpr int COL_Q = 512, COL_C = 1024, COL_IQ = 1152, COL_IK = 1664, COL_IW = 1728;
constexpr float ALPHA = 1.4142135623730951f, LN_EPS = 1e-5f;
constexpr int N_PHASES = 1 + 7 * NLAYER;

constexpr size_t MiB = 1u << 20;
constexpr size_t WS_CTL = 0, CTL_ZERO_BYTES = 1 * MiB;
constexpr size_t WS_SS = 512 * 1024;
constexpr size_t WS_WIN = 1 * MiB;
constexpr size_t WS_WO = 8 * MiB;
constexpr size_t WS_WUP = 14 * MiB;
constexpr size_t WS_WDN = 30 * MiB;
constexpr size_t WS_WUK = 46 * MiB;
constexpr size_t WS_XN = 48 * MiB;
constexpr size_t WS_PROJ = 112 * MiB;
constexpr size_t WS_MIX = 224 * MiB;
constexpr size_t WS_H = 112 * MiB;
constexpr size_t WS_END = 368 * MiB;
static_assert(WS_WIN + (size_t)NLAYER * NP * D * 2 <= WS_WO && WS_WO + (size_t)NLAYER * D * KO * 2 <= WS_WUP && WS_WUP + (size_t)NLAYER * FF * D * 2 <= WS_WDN &&
              WS_WDN + (size_t)NLAYER * D * FF * 2 <= WS_WUK && WS_WUK + (size_t)NLAYER * 128 * 512 * 2 <= WS_XN && WS_XN + (size_t)M * D * 2 <= WS_PROJ &&
              WS_PROJ + (size_t)M * NP * 2 <= WS_MIX && WS_MIX + (size_t)M * KO * 2 <= WS_H + (size_t)M * FF * 2 && WS_H + (size_t)M * FF * 2 <= WS_END, "d_ws map");
constexpr int CW_BAR = 4096;

constexpr int L_MAIN = 0;
constexpr int L_SEL = 131072;
constexpr int L_CAND = 147456;
constexpr int L_LUT = 155648;
constexpr int L_CNT = 160000;
constexpr int L_CCNT = L_CNT + 128;
constexpr int L_THR1 = L_CCNT + 128, L_NEED1 = L_THR1 + 128, L_THR2 = L_NEED1 + 128, L_NEED2 = L_THR2 + 128;
constexpr int L_RBUF = L_NEED2 + 128;
constexpr int L_G = L_RBUF + 1024;
constexpr int L_MISC = L_G + 512;
constexpr int LDS_BYTES = L_MISC + 128;
static_assert(LDS_BYTES <= 163840, "LDS map");

#define GAS __attribute__((address_space(1)))
#define LAS __attribute__((address_space(3)))
typedef unsigned short bf16;
typedef unsigned v4u __attribute__((ext_vector_type(4)));
typedef float f32x4 __attribute__((ext_vector_type(4)));
typedef short bf16x8 __attribute__((ext_vector_type(8)));
typedef GAS unsigned gu32;
typedef GAS unsigned long long gu64;
#define RLX_AGENT __ATOMIC_RELAXED, __HIP_MEMORY_SCOPE_AGENT
#define LDS_WAIT() asm volatile("s_waitcnt lgkmcnt(0)" ::: "memory")
#define VM_WAIT() asm volatile("s_waitcnt vmcnt(0)" ::: "memory")
__device__ __forceinline__ unsigned long long rt() { return __builtin_amdgcn_s_memrealtime(); }
__device__ __forceinline__ unsigned f2bf(float f) { unsigned u = __builtin_bit_cast(unsigned, f); return (u + 0x7fffu + ((u >> 16) & 1u)) >> 16; }
__device__ __forceinline__ unsigned pk2(float lo, float hi) { return f2bf(lo) | (f2bf(hi) << 16); }
#define XB_TMO      128
#define XB_XCNT(j)  (256  + 64 * (j))
#define XB_XSUB(j)  (1280 + 64 * (j))
#define XB_XGEN(j)  (2304 + 64 * (j))
#define XB_TOP      3328
#define XB_TOPGEN   3392
#define XCD_BAR_WORDS 3456
#define XB_SPIN_CAP (1u << 18)

__device__ __forceinline__ unsigned xb_ld(unsigned* p)              { return __hip_atomic_load(p, __ATOMIC_RELAXED, __HIP_MEMORY_SCOPE_AGENT); }
__device__ __forceinline__ unsigned xb_add(unsigned* p, unsigned v) { return __hip_atomic_fetch_add(p, v, __ATOMIC_RELAXED, __HIP_MEMORY_SCOPE_AGENT); }
__device__ __forceinline__ unsigned xb_xcc_id() { return (unsigned)__builtin_amdgcn_s_getreg((3 << 11) | 20) & 0xFu; }
#define XB_SPIN(cond, bar) do { unsigned _sp = 0; while (cond) { __builtin_amdgcn_s_sleep(1); \
    if ((++_sp & 255u) == 0u) { if (xb_ld(&(bar)[XB_TMO])) break; if (_sp > XB_SPIN_CAP) { atomicAdd(&(bar)[XB_TMO], 1u); break; } } } } while (0)

struct XcdBarrier {
    unsigned* bar; unsigned x;
    volatile LAS unsigned* st;
};

__device__ __forceinline__ XcdBarrier xcd_barrier_post(unsigned* bar, volatile LAS unsigned* st) {
    XcdBarrier b; b.bar = bar; b.x = xb_xcc_id(); b.st = st;
    if (threadIdx.x == 0) (void)xb_add(&bar[XB_XCNT(b.x)], 1u);
    return b;
}
__device__ __forceinline__ void xcd_barrier_complete(unsigned* bar, unsigned x, unsigned& nloc, unsigned& nx) {
    const unsigned G = gridDim.x * gridDim.y * gridDim.z;
    unsigned sum, cnt, mine, sp = 0u;
    for (;;) {
        sum = 0u; cnt = 0u; mine = 0u;
#pragma unroll
        for (unsigned j = 0; j < 16; ++j) { const unsigned c = xb_ld(&bar[XB_XCNT(j)]); sum += c; cnt += (c > 0u) ? 1u : 0u; mine = (j == x) ? c : mine; }
        if (sum == G) break;
        __builtin_amdgcn_s_sleep(1);
        if ((++sp & 255u) == 0u) { if (xb_ld(&bar[XB_TMO])) break; if (sp > XB_SPIN_CAP) { atomicAdd(&bar[XB_TMO], 1u); break; } }
    }
    nloc = mine > 0u ? mine : 1u; nx = cnt > 0u ? cnt : 1u;
}

__device__ __forceinline__ void xcd_barrier(const XcdBarrier& b) {
    asm volatile("s_waitcnt vmcnt(0)" ::: "memory");
    __syncthreads();
    if (threadIdx.x == 0) {
        unsigned* bar = b.bar;
        __builtin_amdgcn_s_waitcnt(0);
        unsigned nloc = b.st[0], nx = b.st[1];
        if (nloc == 0u) { xcd_barrier_complete(bar, b.x, nloc, nx); b.st[0] = nloc; b.st[1] = nx; }
        const unsigned old = xb_add(&bar[XB_XSUB(b.x)], 1u);
        const unsigned gen = old / nloc;
        if (old + 1u == (gen + 1u) * nloc) {
            __builtin_amdgcn_fence(__ATOMIC_RELEASE, "agent");
            asm volatile("s_waitcnt vmcnt(0)" ::: "memory");
            const unsigned og = xb_add(&bar[XB_TOP], 1u);
            const unsigned tg = og / nx;
            if (og + 1u == (tg + 1u) * nx) xb_add(&bar[XB_TOPGEN], 1u);
            else XB_SPIN(xb_ld(&bar[XB_TOPGEN]) == tg, bar);
            __builtin_amdgcn_fence(__ATOMIC_ACQUIRE, "agent");
            xb_add(&bar[XB_XGEN(b.x)], 1u);
            asm volatile("s_waitcnt vmcnt(0)" ::: "memory");
        } else {
            XB_SPIN(xb_ld(&bar[XB_XGEN(b.x)]) == gen, bar);
            __builtin_amdgcn_fence(__ATOMIC_ACQUIRE, "agent");
            asm volatile("s_waitcnt vmcnt(0)" ::: "memory");
        }
    }
    __syncthreads();
}
struct Frame {
    LAS unsigned char* lds;
    int tid, lane, wave;
    int vcu, G;
    float* out;
    unsigned char* ws;
};
typedef float f32x2 __attribute__((ext_vector_type(2)));
__device__ __forceinline__ float wave_sum(float v) {
#pragma unroll
    for (int o = 1; o < 64; o <<= 1) v += __shfl_xor(v, o);
    return v;
}
__device__ __forceinline__ float bf2f(unsigned short v) { return __builtin_bit_cast(float, (unsigned)v << 16); }

__device__ __forceinline__ void tr_item(const float* W, int ldw, int nvalid, bf16* dst, int ldd, LAS float* scr, int lane) {
#pragma unroll 8
    for (int i = 0; i < 32; ++i) { const int kk = 2 * i + (lane >> 5), nn = lane & 31; scr[kk * 33 + nn] = nn < nvalid ? W[(size_t)kk * ldw + nn] : 0.f; }
    LDS_WAIT(); asm volatile("" ::: "memory");
    const int c = lane & 7;
#pragma unroll
    for (int j = 0; j < 4; ++j) { const int n = (lane >> 3) + 8 * j; const LAS float* s = scr + (8 * c) * 33 + n;
        v4u o; o.x = pk2(s[0 * 33], s[1 * 33]); o.y = pk2(s[2 * 33], s[3 * 33]); o.z = pk2(s[4 * 33], s[5 * 33]); o.w = pk2(s[6 * 33], s[7 * 33]);
        *(GAS v4u*)(dst + (size_t)n * ldd + 8 * c) = o; }
    LDS_WAIT(); asm volatile("" ::: "memory");
}
__device__ __forceinline__ void ln_row(const float* xrow, const float* g, const float* b, float* orow, bf16* xn, int lane) {
    const GAS f32x4* xr = (const GAS f32x4*)xrow + lane;
    f32x4 v[4]; float s = 0.f;
#pragma unroll
    for (int j = 0; j < 4; ++j) { v[j] = xr[64 * j]; s += (v[j].x + v[j].y) + (v[j].z + v[j].w); }
    const float mean = wave_sum(s) * (1.f / D); float s2 = 0.f;
#pragma unroll
    for (int j = 0; j < 4; ++j) { v[j] = v[j] - mean; s2 += (v[j].x * v[j].x + v[j].y * v[j].y) + (v[j].z * v[j].z + v[j].w * v[j].w); }
    const float rstd = 1.f / sqrtf(wave_sum(s2) * (1.f / D) + LN_EPS);
    GAS f32x4* o4 = (GAS f32x4*)orow + lane;
#pragma unroll
    for (int j = 0; j < 4; ++j) { const f32x4 gg = ((const GAS f32x4*)g)[lane + 64 * j], bb = ((const GAS f32x4*)b)[lane + 64 * j]; v[j] = v[j] * rstd * gg + bb; o4[64 * j] = v[j]; }
    if (xn) { GAS unsigned long long* o8 = (GAS unsigned long long*)xn + lane;
#pragma unroll
        for (int j = 0; j < 4; ++j) o8[64 * j] = (unsigned long long)pk2(v[j].x, v[j].y) | ((unsigned long long)pk2(v[j].z, v[j].w) << 32); }
}
__device__ __forceinline__ void p0_prologue(Frame& F, const float* x_in, const float* emb_g, const float* emb_b, const float* w_in, const float* pool_w, const float* pool_scale,
                                            const float* w_uk, const float* w_uv, const float* w_o, const float* w_up, const float* w_down) {
    LAS float* scr = (LAS float*)(F.lds + L_MAIN + F.wave * 16384);
    const int gw = F.vcu * NWAVES + F.wave, NGW = F.G * NWAVES, lane = F.lane;
    bf16* WIN = (bf16*)(F.ws + WS_WIN); bf16* WO = (bf16*)(F.ws + WS_WO); bf16* WUP = (bf16*)(F.ws + WS_WUP); bf16* WDN = (bf16*)(F.ws + WS_WDN); bf16* WUK = (bf16*)(F.ws + WS_WUK);
    constexpr int I_IN = (D / 64) * 40, I_O = (512 / 64) * (D / 32), I_UP = (D / 64) * (FF / 32), I_DN = (FF / 64) * (D / 32), I_L = I_IN + I_O + I_UP + I_DN;
    for (int it = gw; it < NLAYER * I_L; it += NGW) {
        const int l = it / I_L; int r = it % I_L;
        if (r < I_IN) { const int kb = r / 40, nb = r % 40, n0 = 512 + 32 * nb;
            tr_item(w_in + (size_t)l * D * DIN + (size_t)(64 * kb) * DIN + n0, DIN, DIN - n0, WIN + (size_t)l * NP * D + (size_t)n0 * D + 64 * kb, D, scr, lane); continue; } r -= I_IN;
        if (r < I_O) { const int kb = r / 32, nb = r % 32;
            tr_item(w_o + (size_t)l * D * D + (size_t)(64 * kb) * D + 32 * nb, D, 32, WO + (size_t)l * D * KO + (size_t)(32 * nb) * KO + 64 * kb, KO, scr, lane); continue; } r -= I_O;
        if (r < I_UP) { const int kb = r / 128, nb = r % 128;
            tr_item(w_up + (size_t)l * D * FF + (size_t)(64 * kb) * FF + 32 * nb, FF, 32, WUP + (size_t)l * FF * D + (size_t)(32 * nb) * D + 64 * kb, D, scr, lane); continue; } r -= I_UP;
        { const int kb = r / 32, nb = r % 32;
            tr_item(w_down + (size_t)l * FF * D + (size_t)(64 * kb) * D + 32 * nb, D, 32, WDN + (size_t)l * D * FF + (size_t)(32 * nb) * FF + 64 * kb, FF, scr, lane); }
    }
    for (int it = gw; it < NLAYER * 4 * 128; it += NGW) {
        const int l = it >> 9, g = (it >> 7) & 3, k8 = it & 127;
        const float* wi = w_in + (size_t)l * D * DIN + (size_t)(8 * k8) * DIN + g * 128; const float* pw = pool_w + ((size_t)(l * 4 + g) * 128) * 128;
        float a0[8], a1[8];
#pragma unroll
        for (int kk = 0; kk < 8; ++kk) { a0[kk] = 0.f; a1[kk] = 0.f; }
        for (int c = 0; c < 128; ++c) { const float p0 = pw[c * 128 + lane], p1 = pw[c * 128 + 64 + lane];
#pragma unroll
            for (int kk = 0; kk < 8; ++kk) { const float a = wi[(size_t)kk * DIN + c]; a0[kk] += a * p0; a1[kk] += a * p1; } }
        const float s0 = pool_scale[l * 512 + g * 128 + lane], s1 = pool_scale[l * 512 + g * 128 + 64 + lane];
        v4u o; o.x = pk2(a0[0] * s0, a0[1] * s0); o.y = pk2(a0[2] * s0, a0[3] * s0); o.z = pk2(a0[4] * s0, a0[5] * s0); o.w = pk2(a0[6] * s0, a0[7] * s0);
        *(GAS v4u*)(WIN + (size_t)l * NP * D + (size_t)(g * 128 + lane) * D + 8 * k8) = o;
        o.x = pk2(a1[0] * s1, a1[1] * s1); o.y = pk2(a1[2] * s1, a1[3] * s1); o.z = pk2(a1[4] * s1, a1[5] * s1); o.w = pk2(a1[6] * s1, a1[7] * s1);
        *(GAS v4u*)(WIN + (size_t)l * NP * D + (size_t)(g * 128 + 64 + lane) * D + 8 * k8) = o;
    }
    for (int it = gw; it < NLAYER * 8 * 128; it += NGW) {
        const int l = it >> 10, h = (it >> 7) & 7, n8 = it & 127, nn = lane >> 4, cg = lane & 15;
        const float* uv = w_uv + (size_t)l * 128 * 512 + (size_t)(8 * cg) * 512 + h * 64; const float* wo = w_o + (size_t)l * D * D + (size_t)(512 + h * 64) * D;
#pragma unroll 1
        for (int st = 0; st < 2; ++st) { const int n = n8 * 8 + st * 4 + nn; float a[8];
#pragma unroll
            for (int i = 0; i < 8; ++i) a[i] = 0.f;
            for (int d = 0; d < 64; ++d) { const float w = wo[(size_t)d * D + n];
#pragma unroll
                for (int i = 0; i < 8; ++i) a[i] += uv[i * 512 + d] * w; }
            v4u o; o.x = pk2(a[0], a[1]); o.y = pk2(a[2], a[3]); o.z = pk2(a[4], a[5]); o.w = pk2(a[6], a[7]);
            *(GAS v4u*)(WO + (size_t)l * D * KO + (size_t)n * KO + 512 + h * 128 + 8 * cg) = o; }
    }
    for (int i = gw * 64 + lane; i < NLAYER * 128 * 512; i += NGW * 64) WUK[i] = (bf16)f2bf(w_uk[i] * 0.125f);
    bf16* XN = (bf16*)(F.ws + WS_XN);
    for (int m = gw; m < M; m += NGW) ln_row(x_in + (size_t)m * D, emb_g, emb_b, F.out + (size_t)m * D, XN + (size_t)m * D, lane);
}
__device__ __forceinline__ void ln_phase(Frame& F, const float* g, const float* b, bool write_xn) {
    const int gw = F.vcu * NWAVES + F.wave, NGW = F.G * NWAVES; bf16* XN = (bf16*)(F.ws + WS_XN);
    for (int m = gw; m < M; m += NGW) ln_row(F.out + (size_t)m * D, g, b, F.out + (size_t)m * D, write_xn ? XN + (size_t)m * D : (bf16*)nullptr, F.lane);
}

namespace mixp {
typedef float f32x4 __attribute__((ext_vector_type(4)));
typedef short bf16x8 __attribute__((ext_vector_type(8)));
typedef unsigned short u16;
typedef unsigned short u16x4 __attribute__((ext_vector_type(4)));
typedef unsigned short u16x8 __attribute__((ext_vector_type(8)));
typedef unsigned u32x2 __attribute__((ext_vector_type(2)));

__device__ __forceinline__ unsigned fkey(float f) { const unsigned b = __builtin_bit_cast(unsigned, f); const unsigned m = (unsigned)((int)b >> 31); return b ^ (m | 0x80000000u); }
__device__ __forceinline__ unsigned off_b(unsigned row, unsigned ch) { return 256u * row + 16u * (ch ^ (((row & 3u) << 2) | ((row >> 2) & 3u))); }
__device__ __forceinline__ unsigned cvtpk(float lo, float hi) { unsigned r; asm volatile("v_cvt_pk_bf16_f32 %0, %1, %2" : "=v"(r) : "v"(lo), "v"(hi)); return r; }

__device__ __forceinline__ void scan_hist(LAS unsigned* hist, LAS unsigned* S, bool first, const LAS unsigned* need_in, LAS unsigned* thr_out, LAS unsigned* need_out, int tid) {
    const int q = tid & 31, part = tid >> 5;
    unsigned sum = 0;
#pragma unroll 8
    for (int w = 0; w < 64; ++w) { const unsigned v = hist[(part * 64 + w) * 32 + q]; sum += (v & 0xffffu) + (v >> 16); }
    S[part * 32 + q] = sum;
    if (part == 0) { thr_out[q] = 0x7fffffffu; need_out[q] = 0u; }
    __syncthreads();
    const unsigned need = first ? 256u : need_in[q];
    unsigned above = 0;
#pragma unroll 1
    for (int p2 = part + 1; p2 < 16; ++p2) above += S[p2 * 32 + q];
    if (above < need && above + sum >= need) {
#pragma unroll 1
        for (int w = 63; w >= 0; --w) { const unsigned v = hist[(part * 64 + w) * 32 + q], hi = v >> 16, lo = v & 0xffffu;
            if (above + hi >= need) { thr_out[q] = (unsigned)((part * 64 + w) * 2 + 1); need_out[q] = need - above; break; } above += hi;
            if (above + lo >= need) { thr_out[q] = (unsigned)((part * 64 + w) * 2); need_out[q] = need - above; break; } above += lo; }
    }
    __syncthreads();
}

__device__ __forceinline__ void mix_unit(Frame& F, int layer, int b, int j) {
    const int tid = F.tid, lane = F.lane, wave = F.wave;
    const bf16* PROJ = (const bf16*)(F.ws + WS_PROJ); bf16* MIX = (bf16*)(F.ws + WS_MIX);
    const float* SS = (const float*)(F.ws + WS_SS) + (size_t)layer * M;
    const bf16* WUK = (const bf16*)(F.ws + WS_WUK) + (size_t)layer * 128 * 512;
    LAS unsigned char* lds = F.lds;
    LAS unsigned* hist = (LAS unsigned*)(lds + L_MAIN);
    LAS u16* sel = (LAS u16*)(lds + L_SEL);
    LAS unsigned* cand = (LAS unsigned*)(lds + L_CAND);
    LAS unsigned* Ssum = (LAS unsigned*)(lds + L_CAND);
    LAS unsigned* cnt = (LAS unsigned*)(lds + L_CNT); LAS unsigned* ccnt = (LAS unsigned*)(lds + L_CCNT);
    LAS unsigned* thr1 = (LAS unsigned*)(lds + L_THR1); LAS unsigned* need1 = (LAS unsigned*)(lds + L_NEED1);
    LAS unsigned* thr2 = (LAS unsigned*)(lds + L_THR2); LAS unsigned* need2 = (LAS unsigned*)(lds + L_NEED2);
    const int brow = b * SEQ, t0 = 32 * j, tok0 = brow + t0;

    __syncthreads();
    {
        const int cp = tid & 255, th = tid >> 8, ch = 2 * cp, w = 2 << (ch >> 7), ts = t0 + 16 * th;
        const bf16* up = PROJ + (size_t)brow * NP + ch;
        float s0 = 0.f, s1 = 0.f;
        for (int jj = 1; jj < w; ++jj) { const int tt = ts - jj; if (tt >= 0) { const unsigned v = *(const unsigned*)(up + (size_t)tt * NP); s0 += bf2f((u16)(v & 0xffff)); s1 += bf2f((u16)(v >> 16)); } }
        for (int i = 0; i < 16; ++i) { const int t = ts + i;
            const unsigned v = *(const unsigned*)(up + (size_t)t * NP); const float c0 = bf2f((u16)(v & 0xffff)), c1 = bf2f((u16)(v >> 16));
            s0 += c0; s1 += c1;
            const float inv = 1.0f / (float)(t + 1 < w ? t + 1 : w);
            *(unsigned*)(MIX + (size_t)(brow + t) * KO + ch) = cvtpk(s0 * inv - c0, s1 * inv - c1);
            const int tt = t + 1 - w; if (tt >= 0) { const unsigned o = *(const unsigned*)(up + (size_t)tt * NP); s0 -= bf2f((u16)(o & 0xffff)); s1 -= bf2f((u16)(o >> 16)); } }
    }
    if (tid < 32) { cnt[tid] = 0u; ccnt[tid] = 0u; }
    if (j < 8) {
        for (int i = tid; i < 32 * 256; i += 512) sel[i] = (u16)(i & 255);
        __syncthreads();
        if (tid < 32) cnt[tid] = (unsigned)(t0 + tid + 1);
    } else {
#ifndef DBG_NO_A
        const int qg = wave >> 2, wv = wave & 3, n = lane & 15, g = lane >> 4, q = 16 * qg + n, tq = t0 + q;
        const bf16* qrow = PROJ + (size_t)(tok0 + q) * NP;
        bf16x8 Bq[8][2]; f32x2 wq2[8];
#pragma unroll
        for (int h = 0; h < 8; ++h) { const float wv_ = bf2f(qrow[COL_IW + h]); wq2[h] = (f32x2){wv_, wv_};
#pragma unroll
            for (int s = 0; s < 2; ++s) Bq[h][s] = *(const bf16x8*)(qrow + COL_IQ + 64 * h + 32 * s + 8 * g); }
        const int ktmax = j;
        for (int i = tid; i < 32768; i += 512) hist[i] = 0u;
        __syncthreads();
#pragma unroll 1
        for (int pass = 0; pass < 3; ++pass) {
            const unsigned b1 = pass ? thr1[q] : 0u, b2 = pass == 2 ? thr2[q] : 0u;
#pragma unroll 1
            for (int kt = wv; kt <= ktmax; kt += 4) {
                const bf16* krow = PROJ + (size_t)(brow + 32 * kt + n) * NP + COL_IK + 8 * g;
                bf16x8 A[2][2];
#pragma unroll
                for (int kb = 0; kb < 2; ++kb)
#pragma unroll
                    for (int s = 0; s < 2; ++s) A[kb][s] = *(const bf16x8*)(krow + (size_t)(16 * kb) * NP + 32 * s);
                f32x2 sc2[4];
#pragma unroll
                for (int r = 0; r < 4; ++r) sc2[r] = (f32x2){0.f, 0.f};
#pragma unroll
                for (int h = 0; h < 8; ++h) {
                    f32x4 C[2];
#pragma unroll
                    for (int kb = 0; kb < 2; ++kb) { C[kb] = (f32x4){0.f, 0.f, 0.f, 0.f};
#pragma unroll
                        for (int s = 0; s < 2; ++s) C[kb] = __builtin_amdgcn_mfma_f32_16x16x32_bf16(A[kb][s], Bq[h][s], C[kb], 0, 0, 0); }
#pragma unroll
                    for (int kb = 0; kb < 2; ++kb) {
                        f32x2 r0, r1; r0.x = __builtin_amdgcn_fmed3f(C[kb][0], 0.f, __builtin_inff()); r0.y = __builtin_amdgcn_fmed3f(C[kb][1], 0.f, __builtin_inff());
                        r1.x = __builtin_amdgcn_fmed3f(C[kb][2], 0.f, __builtin_inff()); r1.y = __builtin_amdgcn_fmed3f(C[kb][3], 0.f, __builtin_inff());
                        sc2[kb * 2] = __builtin_elementwise_fma(wq2[h], r0, sc2[kb * 2]); sc2[kb * 2 + 1] = __builtin_elementwise_fma(wq2[h], r1, sc2[kb * 2 + 1]); }
                    if (h & 1) __builtin_amdgcn_sched_barrier(0);
                }
                float sc[8];
#pragma unroll
                for (int r = 0; r < 4; ++r) { sc[2 * r] = sc2[r].x; sc[2 * r + 1] = sc2[r].y; }
                const int key0 = 32 * kt + 4 * g;
                if (kt == ktmax) {
#pragma unroll
                    for (int r = 0; r < 8; ++r) if (key0 + 16 * (r >> 2) + (r & 3) > tq) sc[r] = -__builtin_inff();
                }
                unsigned selmask = 0u;
#ifndef DBG_NO_PROC
#pragma unroll
                for (int r = 0; r < 8; ++r) {
                    const unsigned u = fkey(sc[r]), bin = u >> 21;
                    if (pass == 0) { __hip_atomic_fetch_add(hist + (bin >> 1) * 32 + q, 1u << ((bin & 1u) * 16u), __ATOMIC_RELAXED, __HIP_MEMORY_SCOPE_WORKGROUP); }
                    else if (pass == 1) {
                        if (bin > b1) selmask |= 1u << r;
                        else if (bin == b1) { const unsigned m2 = (u >> 10) & 2047u; __hip_atomic_fetch_add(hist + (m2 >> 1) * 32 + q, 1u << ((m2 & 1u) * 16u), __ATOMIC_RELAXED, __HIP_MEMORY_SCOPE_WORKGROUP); } }
                    else if (bin == b1) {
                        const unsigned m2 = (u >> 10) & 2047u;
                        if (m2 > b2) selmask |= 1u << r;
                        else if (m2 == b2) { const unsigned slot = __hip_atomic_fetch_add(ccnt + q, 1u, __ATOMIC_RELAXED, __HIP_MEMORY_SCOPE_WORKGROUP);
                            if (slot < 64u) cand[q * 64 + slot] = (1u << 22) | ((u & 1023u) << 12) | (unsigned)(4095 - (key0 + 16 * (r >> 2) + (r & 3))); } }
                }
                if (selmask) {
                    unsigned slot = __hip_atomic_fetch_add(cnt + q, (unsigned)__builtin_popcount(selmask), __ATOMIC_RELAXED, __HIP_MEMORY_SCOPE_WORKGROUP);
#pragma unroll
                    for (int r = 0; r < 8; ++r) if (selmask & (1u << r)) { if (slot < 256u) sel[q * 256 + slot] = (u16)(key0 + 16 * (r >> 2) + (r & 3)); ++slot; }
                }
#else
                { float t = 0.f; for (int r = 0; r < 8; ++r) t += sc[r]; if (t == 12345.f) sel[q] = 1; }
#endif
            }
            __syncthreads();
#ifndef DBG_NO_SCAN
            if (pass == 0) { scan_hist(hist, Ssum, true, need1, thr1, need1, tid); for (int i = tid; i < 32768; i += 512) hist[i] = 0u; __syncthreads(); }
            else if (pass == 1) { scan_hist(hist, Ssum, false, need1, thr2, need2, tid); if (tid < 32) ccnt[tid] = 0u; __syncthreads(); }
#endif
        }
        if (tid < 32) {
            const unsigned nc = ccnt[tid] < 64u ? ccnt[tid] : 64u, need = need2[tid]; unsigned base = cnt[tid];
            for (unsigned r = 0; r < need; ++r) { unsigned best = 0u; int bi = -1;
                for (unsigned i = 0; i < nc; ++i) { const unsigned v = cand[tid * 64 + i]; if (v > best) { best = v; bi = (int)i; } }
                if (bi < 0) break;
                if (base < 256u) sel[tid * 256 + base] = (u16)(4095u - (best & 4095u));
                ++base; cand[tid * 64 + bi] = 0u; }
            cnt[tid] = base < 256u ? base : 256u;
        }
#endif
    }
    __syncthreads();
    LAS unsigned char* QL = lds + L_MAIN + 65536;
    const LAS float* gtab = (const LAS float*)(lds + L_G);
    {
        const int h = wave, n = lane & 15, g = lane >> 4;
#pragma unroll 1
        for (int tb = 0; tb < 2; ++tb) {
            const bf16* qp = PROJ + (size_t)(tok0 + 16 * tb + n) * NP + COL_Q + 64 * h + 8 * g;
            const bf16x8 q0 = *(const bf16x8*)qp, q1 = *(const bf16x8*)(qp + 32);
#pragma unroll
            for (int cb = 0; cb < 8; ++cb) {
                const bf16* wp = WUK + (size_t)(16 * cb + n) * 512 + 64 * h + 8 * g;
                f32x4 acc = (f32x4){0.f, 0.f, 0.f, 0.f};
                acc = __builtin_amdgcn_mfma_f32_16x16x32_bf16(*(const bf16x8*)wp, q0, acc, 0, 0, 0);
                acc = __builtin_amdgcn_mfma_f32_16x16x32_bf16(*(const bf16x8*)(wp + 32), q1, acc, 0, 0, 0);
                const f32x4 gg = *(const LAS f32x4*)(gtab + 16 * cb + 4 * g);
                u32x2 o; o.x = cvtpk(acc[0] * gg[0], acc[1] * gg[1]); o.y = cvtpk(acc[2] * gg[2], acc[3] * gg[3]);
                *(LAS u32x2*)(QL + (16 * tb + n) * 2048 + h * 256 + (16 * cb + 4 * g) * 2) = o;
            }
        }
    }
    __syncthreads();
#ifndef DBG_NO_B
    {
        const int n = lane & 15, g = lane >> 4, hh = n & 7, m = n;
        const LAS float* lut = (const LAS float*)(lds + L_LUT);
        LAS float* rbuf = (LAS float*)(lds + L_RBUF) + wave * 32;
        LAS unsigned char* T = lds + L_MAIN + wave * 8192;
        const unsigned tbase = (unsigned)(size_t)T;
        const int kap0 = 8 * (m >> 2) + (m & 3), kap1 = kap0 + 4;
        unsigned tra[8][2];
#pragma unroll
        for (int cb = 0; cb < 8; ++cb)
#pragma unroll
            for (int t = 0; t < 2; ++t) tra[cb][t] = tbase + off_b((unsigned)(8 * g + 4 * t + ((lane & 15) >> 2)), (unsigned)(2 * cb + ((lane & 3) >> 1))) + 8u * (lane & 1);
        unsigned wra[2][4];
#pragma unroll
        for (int s = 0; s < 4; ++s) { wra[0][s] = off_b((unsigned)kap0, (unsigned)(4 * s + g)); wra[1][s] = off_b((unsigned)kap1, (unsigned)(4 * s + g)); }
#pragma unroll 1
        for (int qi = 0; qi < 4; ++qi) {
            const int q = wave * 4 + qi, tq = t0 + q, nv = __builtin_amdgcn_readfirstlane((int)cnt[q]), nch = (nv + 31) >> 5;
            bf16x8 Bq[4];
#pragma unroll
            for (int s = 0; s < 4; ++s) { Bq[s] = *(const LAS bf16x8*)(QL + q * 2048 + hh * 256 + (32 * s + 8 * g) * 2); if (n >= 8) Bq[s] = (bf16x8){0, 0, 0, 0, 0, 0, 0, 0}; }
            float mrun = -1e30f, lrun = 0.f; f32x4 O[8];
#pragma unroll
            for (int cb = 0; cb < 8; ++cb) O[cb] = (f32x4){0.f, 0.f, 0.f, 0.f};
#pragma unroll 1
            for (int ch = 0; ch < nch; ++ch) {
                const int p0 = 32 * ch + kap0, p1 = 32 * ch + kap1;
                const int i0 = p0 < nv ? (int)sel[q * 256 + p0] : 0, i1 = p1 < nv ? (int)sel[q * 256 + p1] : 0;
                const bf16* r0 = PROJ + (size_t)(brow + i0) * NP + COL_C + 8 * g; const bf16* r1 = PROJ + (size_t)(brow + i1) * NP + COL_C + 8 * g;
                bf16x8 a0[4], a1[4];
#pragma unroll
                for (int s = 0; s < 4; ++s) { a0[s] = *(const bf16x8*)(r0 + 32 * s); a1[s] = *(const bf16x8*)(r1 + 32 * s); }
                if (g == 0) { rbuf[kap0] = 1.0f / sqrtf(SS[brow + i0] * (1.0f / 128.0f) + LN_EPS); rbuf[kap1] = 1.0f / sqrtf(SS[brow + i1] * (1.0f / 128.0f) + LN_EPS); }
                f32x4 S0 = (f32x4){0.f, 0.f, 0.f, 0.f}, S1 = (f32x4){0.f, 0.f, 0.f, 0.f};
#pragma unroll
                for (int s = 0; s < 4; ++s) { S0 = __builtin_amdgcn_mfma_f32_16x16x32_bf16(a0[s], Bq[s], S0, 0, 0, 0); S1 = __builtin_amdgcn_mfma_f32_16x16x32_bf16(a1[s], Bq[s], S1, 0, 0, 0); }
#pragma unroll
                for (int s = 0; s < 4; ++s) { *(LAS bf16x8*)(T + wra[0][s]) = a0[s]; *(LAS bf16x8*)(T + wra[1][s]) = a1[s]; }
                asm volatile("s_waitcnt lgkmcnt(0)" ::: "memory");
                const u16x8 id8 = *(const LAS u16x8*)(sel + q * 256 + 32 * ch + 8 * g);
                const f32x4 ra = *(const LAS f32x4*)(rbuf + 8 * g), rb = *(const LAS f32x4*)(rbuf + 8 * g + 4);
                float lg[8], rr[8];
#pragma unroll
                for (int jx = 0; jx < 8; ++jx) { rr[jx] = jx < 4 ? ra[jx] : rb[jx - 4];
                    const int pos = 32 * ch + 8 * g + jx; int dist = tq - (int)id8[jx]; dist = dist < 0 ? 0 : (dist > 128 ? 128 : dist);
                    const float sv = jx < 4 ? S0[jx] : S1[jx - 4];
                    lg[jx] = pos < nv ? sv * rr[jx] + lut[dist * 8 + hh] : -1e30f; }
                float cm = fmaxf(fmaxf(fmaxf(lg[0], lg[1]), fmaxf(lg[2], lg[3])), fmaxf(fmaxf(lg[4], lg[5]), fmaxf(lg[6], lg[7])));
                cm = fmaxf(cm, __shfl_xor(cm, 16)); cm = fmaxf(cm, __shfl_xor(cm, 32));
                const float mnew = fmaxf(mrun, cm), alpha = __builtin_amdgcn_exp2f((mrun - mnew) * 1.44269504f);
                float ps = 0.f, pp[8];
#pragma unroll
                for (int jx = 0; jx < 8; ++jx) { const float p = __builtin_amdgcn_exp2f((lg[jx] - mnew) * 1.44269504f); ps += p; pp[jx] = p * rr[jx]; }
                lrun = lrun * alpha + ps; mrun = mnew;
                union { bf16x8 v; unsigned u[4]; } P;
                P.u[0] = cvtpk(pp[0], pp[1]); P.u[1] = cvtpk(pp[2], pp[3]); P.u[2] = cvtpk(pp[4], pp[5]); P.u[3] = cvtpk(pp[6], pp[7]);
#pragma unroll
                for (int cb = 0; cb < 8; ++cb) O[cb] = O[cb] * alpha;
#pragma unroll
                for (int c4 = 0; c4 < 2; ++c4) {
                    u16x4 x0, x1, x2, x3, x4, x5, x6, x7;
                    asm volatile("ds_read_b64_tr_b16 %0, %8\n\tds_read_b64_tr_b16 %1, %9\n\tds_read_b64_tr_b16 %2, %10\n\tds_read_b64_tr_b16 %3, %11\n\t"
                                 "ds_read_b64_tr_b16 %4, %12\n\tds_read_b64_tr_b16 %5, %13\n\tds_read_b64_tr_b16 %6, %14\n\tds_read_b64_tr_b16 %7, %15\n\ts_waitcnt lgkmcnt(0)"
                                 : "=&v"(x0), "=&v"(x1), "=&v"(x2), "=&v"(x3), "=&v"(x4), "=&v"(x5), "=&v"(x6), "=&v"(x7)
                                 : "v"(tra[4 * c4 + 0][0]), "v"(tra[4 * c4 + 0][1]), "v"(tra[4 * c4 + 1][0]), "v"(tra[4 * c4 + 1][1]),
                                   "v"(tra[4 * c4 + 2][0]), "v"(tra[4 * c4 + 2][1]), "v"(tra[4 * c4 + 3][0]), "v"(tra[4 * c4 + 3][1]) : "memory");
                    union { bf16x8 v; u16x4 h[2]; } A0, A1, A2, A3;
                    A0.h[0] = x0; A0.h[1] = x1; A1.h[0] = x2; A1.h[1] = x3; A2.h[0] = x4; A2.h[1] = x5; A3.h[0] = x6; A3.h[1] = x7;
                    O[4 * c4 + 0] = __builtin_amdgcn_mfma_f32_16x16x32_bf16(A0.v, P.v, O[4 * c4 + 0], 0, 0, 0);
                    O[4 * c4 + 1] = __builtin_amdgcn_mfma_f32_16x16x32_bf16(A1.v, P.v, O[4 * c4 + 1], 0, 0, 0);
                    O[4 * c4 + 2] = __builtin_amdgcn_mfma_f32_16x16x32_bf16(A2.v, P.v, O[4 * c4 + 2], 0, 0, 0);
                    O[4 * c4 + 3] = __builtin_amdgcn_mfma_f32_16x16x32_bf16(A3.v, P.v, O[4 * c4 + 3], 0, 0, 0);
                }
            }
            float lt = lrun; lt += __shfl_xor(lt, 16); lt += __shfl_xor(lt, 32);
            const float inv = 1.0f / lt;
            if (n < 8) {
                bf16* op = MIX + (size_t)(tok0 + q) * KO + 512 + n * 128 + 4 * g;
#pragma unroll
                for (int cb = 0; cb < 8; ++cb) { const f32x4 gg = *(const LAS f32x4*)(gtab + 16 * cb + 4 * g);
                    u32x2 o; o.x = cvtpk(O[cb][0] * inv * gg[0], O[cb][1] * inv * gg[1]); o.y = cvtpk(O[cb][2] * inv * gg[2], O[cb][3] * inv * gg[3]);
                    *(u32x2*)(op + 16 * cb) = o; }
            }
        }
    }
#endif
}

__device__ __forceinline__ void mix_phase(Frame& F, int layer, const float* rel_bias, const float* kvg) {
    LAS float* lut = (LAS float*)(F.lds + L_LUT); LAS float* gtab = (LAS float*)(F.lds + L_G);
    for (int i = F.tid; i < 129 * 8; i += 512) { const int nd = i >> 3, h = i & 7; int bk;
        if (nd < 16) bk = nd; else { bk = 16 + (int)(logf((float)nd / 16.0f) / logf(8.0f) * 16.0f); bk = bk > 31 ? 31 : bk; }
        lut[i] = rel_bias[bk * 8 + h]; }
    if (F.tid < 128) gtab[F.tid] = kvg[F.tid];
    __syncthreads();
#pragma unroll 1
    for (int it = 2 * F.vcu; it < 1024; ++it) { const int p = it >> 1, b = p >> 6, jj = p & 63; mix_unit(F, layer, b, (it & 1) ? 127 - jj : jj); if ((it & 1) && true) it += 2 * F.G - 2; }
    __syncthreads();
}
}

struct Args { const float* in[17]; float* out; unsigned char* ws; int ph_lo, ph_hi; };
static_assert(sizeof(Args) == 17 * 8 + 8 + 8 + 8, "Args has no padding");
#if MK_PER_PHASE
#define GRID_BAR() do { } while (0)
#else
#define GRID_BAR() xcd_barrier(bar)
#endif
#define IN(k) (lo <= (k) && (k) < hi)
#define SEAM(k) do { if (IN((k) + 1)) GRID_BAR(); } while (0)
template <int L>
__device__ __forceinline__ void run_layer(Frame& F, const XcdBarrier& bar, const int lo, const int hi, const float* rel_bias, const float* kvg, const float* ln1g, const float* ln1b, const float* ln2g, const float* ln2b) {
    constexpr int pb = 1 + 7 * L;
    bf16* XN = (bf16*)(F.ws + WS_XN); bf16* PROJ = (bf16*)(F.ws + WS_PROJ); bf16* MIX = (bf16*)(F.ws + WS_MIX); bf16* HB = (bf16*)(F.ws + WS_H);
#ifndef DBG_NO_GEMM
    if (IN(pb + 0)) {
        pg8::Gemm g{XN, (const bf16*)(F.ws + WS_WIN) + (size_t)L * NP * D, M, NP, D}; pg8::StaticOrder S; S.init(M, NP, F.G, (int)blockIdx.x);
        pg8::EpiProj E{PROJ, NP, (float*)(F.ws + WS_SS) + (size_t)L * M};
        pg8::gemm_phase<pg8::EpiProj, pg8::StaticOrder, PG8_ALIGN, PG8_SP2>(F.lds + L_MAIN, g, S, E);
        SEAM(pb + 0);
    }
#endif
#ifndef DBG_NO_MIX
    if (IN(pb + 1)) { mixp::mix_phase(F, L, rel_bias, kvg); SEAM(pb + 1); }
#endif
#ifndef DBG_NO_GEMM
    if (IN(pb + 2)) {
        pg8::Gemm g{MIX, (const bf16*)(F.ws + WS_WO) + (size_t)L * D * KO, M, D, KO}; pg8::StaticOrder S; S.init(M, D, F.G, (int)blockIdx.x);
        pg8::EpiRes E{F.out, D, ALPHA};
        pg8::gemm_phase<pg8::EpiRes, pg8::StaticOrder, PG8_ALIGN, PG8_SP2>(F.lds + L_MAIN, g, S, E);
        SEAM(pb + 2);
    }
    if (IN(pb + 3)) { ln_phase(F, ln1g, ln1b, true); SEAM(pb + 3); }
    if (IN(pb + 4)) {
        pg8::Gemm g{XN, (const bf16*)(F.ws + WS_WUP) + (size_t)L * FF * D, M, FF, D}; pg8::StaticOrder S; S.init(M, FF, F.G, (int)blockIdx.x);
        pg8::EpiRelu2 E{HB, FF};
        pg8::gemm_phase<pg8::EpiRelu2, pg8::StaticOrder, PG8_ALIGN, PG8_SP2>(F.lds + L_MAIN, g, S, E);
        SEAM(pb + 4);
    }
    if (IN(pb + 5)) {
        pg8::Gemm g{HB, (const bf16*)(F.ws + WS_WDN) + (size_t)L * D * FF, M, D, FF}; pg8::StaticOrder S; S.init(M, D, F.G, (int)blockIdx.x);
        pg8::EpiRes E{F.out, D, ALPHA};
        pg8::gemm_phase<pg8::EpiRes, pg8::StaticOrder, PG8_ALIGN, PG8_SP2>(F.lds + L_MAIN, g, S, E);
        SEAM(pb + 5);
    }
#endif
    if (IN(pb + 6)) { ln_phase(F, ln2g, ln2b, L + 1 < NLAYER); if (L + 1 < NLAYER) SEAM(pb + 6); }
}
__global__ void __launch_bounds__(NWAVES * 64, 2) hymba_fwd(Args args) {
    extern __shared__ __attribute__((aligned(16))) unsigned char lds[];
    Frame F;
    F.lds = (LAS unsigned char*)lds;
    F.tid = threadIdx.x; F.lane = F.tid & 63; F.wave = __builtin_amdgcn_readfirstlane(F.tid >> 6);
    F.G = gridDim.x; { const int bx = blockIdx.x; F.vcu = (F.G % 8 == 0) ? (bx % 8) * (F.G / 8) + bx / 8 : bx; }
    F.out = args.out; F.ws = args.ws;
    volatile LAS unsigned* MISC = (volatile LAS unsigned*)(F.lds + L_MISC);
    if (F.tid < 32) MISC[F.tid] = 0u;
    __syncthreads();
    XcdBarrier bar; bar.bar = (unsigned*)(F.ws + WS_CTL) + CW_BAR; bar.x = 0; bar.st = nullptr;
#if !MK_PER_PHASE
    bar = xcd_barrier_post((unsigned*)(F.ws + WS_CTL) + CW_BAR, MISC + 8);
#endif
    const int lo = args.ph_lo, hi = args.ph_hi;
#ifndef DBG_NO_PRO
    if (IN(0)) { p0_prologue(F, args.in[0], args.in[1], args.in[2], args.in[4], args.in[5], args.in[6], args.in[8], args.in[9], args.in[10], args.in[13], args.in[14]); SEAM(0); }
#endif
    run_layer<0>(F, bar, lo, hi, args.in[3], args.in[7], args.in[11], args.in[12], args.in[15], args.in[16]);
    run_layer<1>(F, bar, lo, hi, args.in[3], args.in[7] + 128, args.in[11] + D, args.in[12] + D, args.in[15] + D, args.in[16] + D);
}
#undef IN
#undef SEAM
#undef GRID_BAR

extern "C" void kernel_launch(void* const* d_in, const int* in_sizes, int n_in, void* d_out, int out_size, void* d_ws, size_t ws_size, hipStream_t stream) {
    static int grid = 0;
    if (grid == 0) {
        if (n_in != 17 || in_sizes[0] != M * D || out_size != M * D || ws_size < WS_END) { fprintf(stderr, "kernel_launch: unexpected shapes (n_in %d, in0 %d, out %d, ws %zu)\n", n_in, n_in > 0 ? in_sizes[0] : -1, out_size, ws_size); grid = -1; return; }
        int dev = 0, cus = 0, per_cu = 0;
        if (hipGetDevice(&dev) != hipSuccess || hipDeviceGetAttribute(&cus, hipDeviceAttributeMultiprocessorCount, dev) != hipSuccess) { grid = -1; return; }
        if (hipFuncSetAttribute((const void*)hymba_fwd, hipFuncAttributeMaxDynamicSharedMemorySize, LDS_BYTES) != hipSuccess) { fprintf(stderr, "kernel_launch: hipFuncSetAttribute failed\n"); grid = -1; return; }
        if (hipOccupancyMaxActiveBlocksPerMultiprocessor(&per_cu, (const void*)hymba_fwd, NWAVES * 64, LDS_BYTES) != hipSuccess || per_cu < 1) { fprintf(stderr, "kernel_launch: occupancy query says %d blocks per CU\n", per_cu); per_cu = 1; }
        (void)hipGetLastError();
        grid = cus;
    }
    if (grid < 0) return;
    (void)hipMemsetAsync((char*)d_ws + WS_CTL, 0, CTL_ZERO_BYTES, stream);
    Args a{};
    for (int i = 0; i < 17; ++i) a.in[i] = (const float*)d_in[i];
    a.out = (float*)d_out; a.ws = (unsigned char*)d_ws;
#if MK_PER_PHASE
    for (int p = 0; p < N_PHASES; ++p) { a.ph_lo = p; a.ph_hi = p + 1; hipLaunchKernelGGL(hymba_fwd, dim3(grid), dim3(NWAVES * 64), LDS_BYTES, stream, a); }
#else
    a.ph_lo = 0; a.ph_hi = N_PHASES;
    hipLaunchKernelGGL(hymba_fwd, dim3(grid), dim3(NWAVES * 64), LDS_BYTES, stream, a);
#endif
    const hipError_t le = hipPeekAtLastError();
    if (le != hipSuccess) fprintf(stderr, "kernel_launch: launch failed: %s\n", hipGetErrorName(le));
}
```

```cpp
#define MK_PER_PHASE 0
#ifndef DBG_SKIP
#define DBG_SKIP 0
#endif
#ifndef DBG_REPM
#define DBG_REPM 0
#endif
#ifndef DBG_REP
#define DBG_REP 0
#endif
#include <hip/hip_runtime.h>
#include <cstdio>
#include <cstdint>
namespace pg8 {
#define PG8_LAS __attribute__((address_space(3)))
typedef unsigned short bf16_t;
typedef short bf16x8 __attribute__((ext_vector_type(8)));
typedef float f32x4 __attribute__((ext_vector_type(4)));
typedef unsigned u32x4 __attribute__((ext_vector_type(4)));
constexpr int BM = 256, BK = 64, HALF = 128, HTB = HALF * BK * 2  , STAGE_BYTES = 8 * HTB, NXCD = 8, WGM = 8;

__host__ __device__ __forceinline__ int lds_byte(int r, int c) { const int st = (r >> 4) * 2 + (c >> 5), rr = r & 15, cc = c & 31, ob = rr * 64 + cc * 2; return st * 1024 + (ob ^ (((ob >> 9) & 1) << 5)); }
__host__ __device__ __forceinline__ void stage_rc(int b, int& R, int& C) { const int st = b / 1024, sb = b % 1024, swz = sb ^ (((sb >> 9) & 1) << 5); R = (st >> 1) * 16 + swz / 64; C = (st & 1) * 32 + (swz % 64) / 2; }
__host__ __device__ __forceinline__ int perm32(int rho) { const int n = rho >> 4, i = rho & 15; return 8 * (i >> 2) + 4 * n + (i & 3); }

struct Unit { int pm, pn; };
struct Gemm { const bf16_t* A; const bf16_t* Bt; int M, N, K; };

struct StaticOrder {
    int nM, nN, nwg, G, c;
    __host__ __device__ void init(int M, int N, int G_, int c_) { nM = M / BM; nN = N / BM; nwg = nM * nN; G = G_; c = c_; }
    __host__ __device__ bool next(int i, Unit& u) const {
        const long L = (long)i * G + c; if (L >= nwg) return false;
        int wgid = (int)L; { const int q = nwg / NXCD, r = nwg % NXCD, xcd = wgid % NXCD, off = wgid / NXCD; wgid = (xcd < r ? xcd * (q + 1) : r * (q + 1) + (xcd - r) * q) + off; }
        const int nig = WGM * nN, gid = wgid / nig, fm = gid * WGM, gsz = (nM - fm) < WGM ? (nM - fm) : WGM;
        u.pm = fm + ((wgid % nig) % gsz); u.pn = (wgid % nig) / gsz; return true;
    }
    __device__ __forceinline__ void a_ready(const Unit&) const {}
    __device__ __forceinline__ void done(const Unit&) const {}
};

__device__ __forceinline__ unsigned cvt_pk_bf16(float lo, float hi) { unsigned r; asm volatile("v_cvt_pk_bf16_f32 %0, %1, %2" : "=v"(r) : "v"(lo), "v"(hi)); return r; }

struct EpiProj {
    static constexpr bool PERM = true, AFTER_DRAIN = false;
    bf16_t* O; int ldc; float* ss;
    __device__ __forceinline__ void operator()(const f32x4 (&acc)[2][2][4][2], const Unit& u, int wr, int wc, int fr, int fq) const {
        const int row0 = u.pm * BM + wr * 64 + fr, col0 = u.pn * BM + wc * 32 + 8 * fq;
#pragma unroll
        for (int ai = 0; ai < 2; ++ai)
#pragma unroll
            for (int m = 0; m < 4; ++m) { bf16_t* rowp = O + (size_t)(row0 + ai * HALF + m * 16) * ldc + col0;
#pragma unroll
                for (int bj = 0; bj < 2; ++bj) { const f32x4 v0 = acc[ai][bj][m][0], v1 = acc[ai][bj][m][1];
                    u32x4 w; w.x = cvt_pk_bf16(v0[0], v0[1]); w.y = cvt_pk_bf16(v0[2], v0[3]); w.z = cvt_pk_bf16(v1[0], v1[1]); w.w = cvt_pk_bf16(v1[2], v1[3]);
                    *(u32x4*)(rowp + bj * HALF) = w; } }
        if (u.pn == 4) {
#pragma unroll
            for (int ai = 0; ai < 2; ++ai)
#pragma unroll
                for (int m = 0; m < 4; ++m) { const f32x4 v0 = acc[ai][0][m][0], v1 = acc[ai][0][m][1];
                    float s = (v0[0] * v0[0] + v0[1] * v0[1]) + (v0[2] * v0[2] + v0[3] * v0[3]) + (v1[0] * v1[0] + v1[1] * v1[1]) + (v1[2] * v1[2] + v1[3] * v1[3]);
                    s += __shfl_xor(s, 16); s += __shfl_xor(s, 32);
                    if (fq == 0) ss[(size_t)(row0 + ai * HALF + m * 16) * 4 + wc] = s; }
        }
    }
};
struct EpiRes {
    static constexpr bool PERM = true, AFTER_DRAIN = false;
    bf16_t* X; int ldc; float alpha;
    __device__ __forceinline__ void operator()(const f32x4 (&acc)[2][2][4][2], const Unit& u, int wr, int wc, int fr, int fq) const {
        const int row0 = u.pm * BM + wr * 64 + fr, col0 = u.pn * BM + wc * 32 + 8 * fq;
#pragma unroll
        for (int ai = 0; ai < 2; ++ai)
#pragma unroll
            for (int m = 0; m < 4; ++m) { bf16_t* rowp = X + (size_t)(row0 + ai * HALF + m * 16) * ldc + col0;
                u32x4 xin[2];
#pragma unroll
                for (int bj = 0; bj < 2; ++bj) xin[bj] = *(const u32x4*)(rowp + bj * HALF);
#pragma unroll
                for (int bj = 0; bj < 2; ++bj) { const f32x4 v0 = acc[ai][bj][m][0], v1 = acc[ai][bj][m][1]; const u32x4 x = xin[bj];
#define PG8_LO(w) __builtin_bit_cast(float, (w) << 16)
#define PG8_HI(w) __builtin_bit_cast(float, (w) & 0xffff0000u)
                    u32x4 w; w.x = cvt_pk_bf16(PG8_LO(x.x) * alpha + v0[0], PG8_HI(x.x) * alpha + v0[1]); w.y = cvt_pk_bf16(PG8_LO(x.y) * alpha + v0[2], PG8_HI(x.y) * alpha + v0[3]);
                    w.z = cvt_pk_bf16(PG8_LO(x.z) * alpha + v1[0], PG8_HI(x.z) * alpha + v1[1]); w.w = cvt_pk_bf16(PG8_LO(x.w) * alpha + v1[2], PG8_HI(x.w) * alpha + v1[3]);
#undef PG8_LO
#undef PG8_HI
                    *(u32x4*)(rowp + bj * HALF) = w; }
                asm volatile("" ::: "memory"); }
    }
};
struct EpiRelu2 {
    static constexpr bool PERM = true, AFTER_DRAIN = false;
    bf16_t* O; int ldc;
    __device__ __forceinline__ void operator()(const f32x4 (&acc)[2][2][4][2], const Unit& u, int wr, int wc, int fr, int fq) const {
        const int row0 = u.pm * BM + wr * 64 + fr, col0 = u.pn * BM + wc * 32 + 8 * fq;
#pragma unroll
        for (int ai = 0; ai < 2; ++ai)
#pragma unroll
            for (int m = 0; m < 4; ++m) { bf16_t* rowp = O + (size_t)(row0 + ai * HALF + m * 16) * ldc + col0;
#pragma unroll
                for (int bj = 0; bj < 2; ++bj) { f32x4 v0 = acc[ai][bj][m][0], v1 = acc[ai][bj][m][1];
#pragma unroll
                    for (int j = 0; j < 4; ++j) { const float a = fmaxf(v0[j], 0.f), b = fmaxf(v1[j], 0.f); v0[j] = a * a; v1[j] = b * b; }
                    u32x4 w; w.x = cvt_pk_bf16(v0[0], v0[1]); w.y = cvt_pk_bf16(v0[2], v0[3]); w.z = cvt_pk_bf16(v1[0], v1[1]); w.w = cvt_pk_bf16(v1[2], v1[3]);
                    *(u32x4*)(rowp + bj * HALF) = w; } }
    }
};

template <class Epi, class Sched, bool ALIGN_EPI = false, bool SP2 = false>
__device__ __forceinline__ void gemm_phase(PG8_LAS unsigned char* lds, const Gemm g, const Sched& S, const Epi& E) {
    const int tid = threadIdx.x, wid = __builtin_amdgcn_readfirstlane(tid >> 6), lane = tid & 63, wr = wid >> 2, wc = wid & 3, fr = lane & 15, fq = lane >> 4;
    const int K = g.K, nt = K / BK;
    unsigned voffA[2], voffB[2];
#pragma unroll
    for (int i = 0; i < 2; ++i) { int R, C; stage_rc(tid * 16 + i * 8192, R, C); const int Rb = Epi::PERM ? ((R & ~31) + perm32(R & 31)) : R;
        voffA[i] = (unsigned)(R * K + C) * 2u; voffB[i] = (unsigned)(Rb * K + C) * 2u; }
    const size_t kstep = (size_t)(BK * 2);
    const size_t hstep = (size_t)HALF * K * 2;
    const size_t tstep = 2 * hstep;
    const unsigned ldsw = (unsigned)wid * 1024u;
    const int aoff = lds_byte(wr * 64 + fr, fq * 8), boff = lds_byte(wc * 32 + fr, fq * 8);
#define PG8_SA(b, h) (((b) * 2 + (h)) * HTB)
#define PG8_SB(b, h) ((4 + (b) * 2 + (h)) * HTB)
#define PG8_STAGE(bufoff, gbase, voff) do { _Pragma("unroll") for (int _i = 0; _i < 2; ++_i) \
        __builtin_amdgcn_global_load_lds((const unsigned*)((const char*)(gbase) + (voff)[_i]), (PG8_LAS unsigned*)(lds + (bufoff) + ldsw + _i * 8192), 16, 0, 0); } while (0)
#define PG8_LDA(dst, b, h) do { _Pragma("unroll") for (int m = 0; m < 4; ++m) _Pragma("unroll") for (int k = 0; k < 2; ++k) dst[m][k] = *(const PG8_LAS bf16x8*)(lds + PG8_SA(b, h) + aoff + m * 2048 + k * 1024); } while (0)
#define PG8_LDB(dst, b, h) do { _Pragma("unroll") for (int n = 0; n < 2; ++n) _Pragma("unroll") for (int k = 0; k < 2; ++k) dst[n][k] = *(const PG8_LAS bf16x8*)(lds + PG8_SB(b, h) + boff + n * 2048 + k * 1024); } while (0)
#define PG8_MMA(ai, bj, At, Bt) do { __builtin_amdgcn_s_setprio(1); _Pragma("unroll") for (int m = 0; m < 4; ++m) _Pragma("unroll") for (int n = 0; n < 2; ++n) _Pragma("unroll") for (int k = 0; k < 2; ++k) \
        acc[ai][bj][m][n] = __builtin_amdgcn_mfma_f32_16x16x32_bf16(Bt[n][k], At[m][k], acc[ai][bj][m][n], 0, 0, 0); __builtin_amdgcn_s_setprio(0); } while (0)
#define PG8_WAIT_V(n) asm volatile("s_waitcnt vmcnt(" #n ")" ::: "memory")
#define PG8_WAIT_L(n) asm volatile("s_waitcnt lgkmcnt(" #n ")" ::: "memory")
#define PG8_BAR __builtin_amdgcn_s_barrier()
#define PG8_SCHED __builtin_amdgcn_sched_barrier(0)
    Unit cur, nxt; int ui = 0;
    if (!S.next(0, cur)) return;
    f32x4 acc[2][2][4][2];
#pragma unroll
    for (int a = 0; a < 2; ++a)
#pragma unroll
        for (int b = 0; b < 2; ++b)
#pragma unroll
            for (int m = 0; m < 4; ++m)
#pragma unroll
                for (int n = 0; n < 2; ++n) acc[a][b][m][n] = (f32x4){0.f, 0.f, 0.f, 0.f};
    bf16x8 At[4][2], B0[2][2], B1[2][2];
    const char* cA = (const char*)g.A + (size_t)cur.pm * tstep; const char* cB = (const char*)g.Bt + (size_t)cur.pn * tstep;
    S.a_ready(cur);
    if constexpr (SP2) {
        PG8_STAGE(PG8_SB(0, 0), cB, voffB); PG8_STAGE(PG8_SB(0, 1), cB + hstep, voffB); PG8_STAGE(PG8_SA(0, 0), cA, voffA); PG8_STAGE(PG8_SA(0, 1), cA + hstep, voffA);
        if (wr == 1) PG8_BAR;
        PG8_WAIT_V(2); PG8_BAR;
        PG8_STAGE(PG8_SB(1, 0), cB + kstep, voffB); PG8_STAGE(PG8_SA(1, 0), cA + kstep, voffA); PG8_STAGE(PG8_SB(1, 1), cB + hstep + kstep, voffB);
        PG8_WAIT_V(6); PG8_BAR;
    } else {
        PG8_STAGE(PG8_SB(0, 0), cB, voffB); PG8_STAGE(PG8_SA(0, 0), cA, voffA); PG8_STAGE(PG8_SB(0, 1), cB + hstep, voffB); PG8_STAGE(PG8_SA(0, 1), cA + hstep, voffA);
        if (wr == 1) PG8_BAR;
        PG8_WAIT_V(4); PG8_BAR;
        PG8_STAGE(PG8_SB(1, 0), cB + kstep, voffB); PG8_STAGE(PG8_SA(1, 0), cA + kstep, voffA); PG8_STAGE(PG8_SB(1, 1), cB + hstep + kstep, voffB);
        PG8_WAIT_V(6); PG8_BAR;
    }
    for (;;) {
        const bool has_next = S.next(ui + 1, nxt);
        const char* nA = has_next ? (const char*)g.A + (size_t)nxt.pm * tstep : cA; const char* nB = has_next ? (const char*)g.Bt + (size_t)nxt.pn * tstep : cB;
        for (int t = 0; t < nt; t += 2) {
            const bool last = (t == nt - 2);
            const char* a1 = cA + (size_t)(t + 1) * kstep;
            const char* a2 = last ? nA : cA + (size_t)(t + 2) * kstep; const char* b2 = last ? nB : cB + (size_t)(t + 2) * kstep;
            const char* a3 = a2 + kstep; const char* b3 = b2 + kstep;
            if (last && has_next) S.a_ready(nxt);
            if constexpr (SP2) {
            PG8_LDB(B0, 0, 0); PG8_LDB(B1, 0, 1); PG8_SCHED; PG8_LDA(At, 0, 0); PG8_STAGE(PG8_SA(1, 1), a1 + hstep, voffA);
            PG8_WAIT_V(8); PG8_WAIT_L(0); PG8_BAR; PG8_MMA(0, 0, At, B0); PG8_MMA(0, 1, At, B1); PG8_BAR; PG8_SCHED;
            PG8_LDA(At, 0, 1); PG8_STAGE(PG8_SB(0, 0), b2, voffB); PG8_STAGE(PG8_SB(0, 1), b2 + hstep, voffB); PG8_STAGE(PG8_SA(0, 0), a2, voffA);
            PG8_WAIT_V(8); PG8_WAIT_L(0); PG8_BAR; PG8_MMA(1, 0, At, B0); PG8_MMA(1, 1, At, B1); PG8_BAR; PG8_SCHED;
            PG8_LDB(B0, 1, 0); PG8_LDB(B1, 1, 1); PG8_SCHED; PG8_LDA(At, 1, 0); PG8_STAGE(PG8_SA(0, 1), a2 + hstep, voffA);
            PG8_WAIT_V(8); PG8_WAIT_L(0); PG8_BAR; PG8_MMA(0, 0, At, B0); PG8_MMA(0, 1, At, B1); PG8_BAR; PG8_SCHED;
            PG8_LDA(At, 1, 1); PG8_STAGE(PG8_SB(1, 0), b3, voffB); PG8_STAGE(PG8_SB(1, 1), b3 + hstep, voffB); PG8_STAGE(PG8_SA(1, 0), a3, voffA);
            PG8_WAIT_V(8); PG8_WAIT_L(0); PG8_BAR; PG8_MMA(1, 0, At, B0); PG8_MMA(1, 1, At, B1); PG8_BAR; PG8_SCHED;
            } else {
            PG8_LDB(B0, 0, 0); PG8_SCHED; PG8_LDA(At, 0, 0); PG8_STAGE(PG8_SA(1, 1), a1 + hstep, voffA);
            PG8_WAIT_L(8); PG8_BAR; PG8_WAIT_L(0); PG8_MMA(0, 0, At, B0); PG8_BAR; PG8_SCHED;
            PG8_LDB(B1, 0, 1); PG8_STAGE(PG8_SB(0, 0), b2, voffB);
            PG8_BAR; PG8_WAIT_L(0); PG8_MMA(0, 1, At, B1); PG8_BAR;
            PG8_LDA(At, 0, 1); PG8_STAGE(PG8_SA(0, 0), a2, voffA);
            PG8_BAR; PG8_WAIT_L(0); PG8_MMA(1, 0, At, B0); PG8_BAR; PG8_SCHED;
            PG8_STAGE(PG8_SB(0, 1), b2 + hstep, voffB);
            PG8_WAIT_V(6); PG8_BAR; PG8_MMA(1, 1, At, B1); PG8_BAR;
            PG8_LDB(B0, 1, 0); PG8_SCHED; PG8_LDA(At, 1, 0); PG8_STAGE(PG8_SA(0, 1), a2 + hstep, voffA);
            PG8_WAIT_L(8); PG8_BAR; PG8_WAIT_L(0); PG8_MMA(0, 0, At, B0); PG8_BAR; PG8_SCHED;
            PG8_LDB(B1, 1, 1); PG8_STAGE(PG8_SB(1, 0), b3, voffB);
            PG8_BAR; PG8_WAIT_L(0); PG8_MMA(0, 1, At, B1); PG8_BAR;
            PG8_LDA(At, 1, 1); PG8_STAGE(PG8_SA(1, 0), a3, voffA);
            PG8_BAR; PG8_WAIT_L(0); PG8_MMA(1, 0, At, B0); PG8_BAR; PG8_SCHED;
            PG8_STAGE(PG8_SB(1, 1), b3 + hstep, voffB);
            PG8_WAIT_V(6); PG8_BAR; PG8_MMA(1, 1, At, B1); PG8_BAR;
            }
        }
        if constexpr (ALIGN_EPI) { if (wr == 0) PG8_BAR; }
        if constexpr (!Epi::AFTER_DRAIN) { E(acc, cur, wr, wc, fr, fq); S.done(cur); }
        if (!has_next) break;
#pragma unroll
        for (int a = 0; a < 2; ++a)
#pragma unroll
            for (int b = 0; b < 2; ++b)
#pragma unroll
                for (int m = 0; m < 4; ++m)
#pragma unroll
                    for (int n = 0; n < 2; ++n) acc[a][b][m][n] = (f32x4){0.f, 0.f, 0.f, 0.f};
        cur = nxt; cA = nA; cB = nB; ++ui;
        if constexpr (ALIGN_EPI) { if (wr == 1) PG8_BAR; }
    }
    PG8_WAIT_V(0);
    if constexpr (!ALIGN_EPI) { if (wr == 0) PG8_BAR; }
    PG8_BAR;
    if constexpr (Epi::AFTER_DRAIN) { E.fused(acc, cur, wr, wc, fr, fq, lds, wid, lane); S.done(cur); }
#undef PG8_SA
#undef PG8_SB
#undef PG8_STAGE
#undef PG8_LDA
#undef PG8_LDB
#undef PG8_MMA
#undef PG8_WAIT_V
#undef PG8_WAIT_L
#undef PG8_BAR
#undef PG8_SCHED
}
}
#ifndef PG8_SP2
#define PG8_SP2 true
#endif
#ifndef PG8_ALIGN
#define PG8_ALIGN true
#endif
constexpr int NWAVES = 8;
#ifndef MK_PER_PHASE
#define MK_PER_PHASE 0
#endif

constexpr int BATCH = 8, SEQ = 4096, D = 1024, M = BATCH * SEQ, DIN = 1736, NP = 1792, FF = 4096, KO = 1536, NLAYER = 2;
constexpr int COL_Q = 512, COL_C = 1024, COL_IQ = 1152, COL_IK = 1664, COL_IW = 1728;
constexpr float ALPHA = 1.4142135623730951f, LN_EPS = 1e-5f;
constexpr int N_PHASES = 1 + 7 * NLAYER;

constexpr size_t MiB = 1u << 20;
constexpr size_t WS_CTL = 0, CTL_ZERO_BYTES = 1 * MiB;
constexpr size_t WS_SS = 47 * MiB;
constexpr size_t WS_WIN = 1 * MiB;
constexpr size_t WS_WO = 8 * MiB;
constexpr size_t WS_WUP = 14 * MiB;
constexpr size_t WS_WDN = 30 * MiB;
constexpr size_t WS_WUK = 46 * MiB;
constexpr size_t WS_XN = 48 * MiB;
constexpr size_t WS_PROJ = 112 * MiB;
constexpr size_t WS_MIX = 224 * MiB;
constexpr size_t WS_H = 112 * MiB;
constexpr size_t WS_END = 368 * MiB;
static_assert(WS_WIN + (size_t)NLAYER * NP * D * 2 <= WS_WO && WS_WO + (size_t)NLAYER * D * KO * 2 <= WS_WUP && WS_WUP + (size_t)NLAYER * FF * D * 2 <= WS_WDN &&
              WS_WDN + (size_t)NLAYER * D * FF * 2 <= WS_WUK && WS_WUK + (size_t)NLAYER * 128 * 512 * 2 <= WS_XN && WS_XN + (size_t)M * D * 2 <= WS_PROJ &&
              WS_PROJ + (size_t)M * NP * 2 <= WS_MIX && WS_MIX + (size_t)M * KO * 2 <= WS_H + (size_t)M * FF * 2 && WS_H + (size_t)M * FF * 2 <= WS_END, "d_ws map");
constexpr int CW_BAR = 4096;

constexpr int L_MAIN = 0;
constexpr int L_SEL = 131072;
constexpr int L_WH = L_SEL + 8192;
constexpr int L_SS = L_WH + 4096;
constexpr int L_LUT = L_SS + 2048;
constexpr int L_CNT = L_LUT + 4352;
constexpr int L_CCNT = L_CNT + 128;
constexpr int L_THR1 = L_CCNT + 128, L_NEED1 = L_THR1 + 128;
constexpr int L_RBUF = L_NEED1 + 128;
constexpr int L_G = L_RBUF + 1024;
constexpr int L_BM = L_G + 512;
constexpr int L_MISC = L_BM + 8192;
constexpr int LDS_BYTES = L_MISC + 128;
static_assert(LDS_BYTES <= 163840 && LDS_BYTES > 81920, "LDS map (more than half of the CU's LDS: exactly one workgroup per CU)");

#define GAS __attribute__((address_space(1)))
#define LAS __attribute__((address_space(3)))
typedef unsigned short bf16;
typedef unsigned v4u __attribute__((ext_vector_type(4)));
typedef float f32x4 __attribute__((ext_vector_type(4)));
typedef short bf16x8 __attribute__((ext_vector_type(8)));
typedef GAS unsigned gu32;
typedef GAS unsigned long long gu64;
#define RLX_AGENT __ATOMIC_RELAXED, __HIP_MEMORY_SCOPE_AGENT
#define LDS_WAIT() asm volatile("s_waitcnt lgkmcnt(0)" ::: "memory")
#define VM_WAIT() asm volatile("s_waitcnt vmcnt(0)" ::: "memory")
__device__ __forceinline__ unsigned long long rt() { return __builtin_amdgcn_s_memrealtime(); }
__device__ __forceinline__ unsigned f2bf(float f) { unsigned u = __builtin_bit_cast(unsigned, f); return (u + 0x7fffu + ((u >> 16) & 1u)) >> 16; }
__device__ __forceinline__ unsigned pk2(float lo, float hi) { return f2bf(lo) | (f2bf(hi) << 16); }
#define XB_TMO      128
#define XB_XCNT(j)  (256  + 64 * (j))
#define XB_XSUB(j)  (1280 + 64 * (j))
#define XB_XGEN(j)  (2304 + 64 * (j))
#define XB_TOP      3328
#define XB_TOPGEN   3392
#define XCD_BAR_WORDS 3456
#define XB_SPIN_CAP (1u << 18)

__device__ __forceinline__ unsigned xb_ld(unsigned* p)              { return __hip_atomic_load(p, __ATOMIC_RELAXED, __HIP_MEMORY_SCOPE_AGENT); }
__device__ __forceinline__ unsigned xb_add(unsigned* p, unsigned v) { return __hip_atomic_fetch_add(p, v, __ATOMIC_RELAXED, __HIP_MEMORY_SCOPE_AGENT); }
__device__ __forceinline__ unsigned xb_xcc_id() { return (unsigned)__builtin_amdgcn_s_getreg((3 << 11) | 20) & 0xFu; }
#define XB_SPIN(cond, bar) do { unsigned _sp = 0; while (cond) { __builtin_amdgcn_s_sleep(1); \
    if ((++_sp & 255u) == 0u) { if (xb_ld(&(bar)[XB_TMO])) break; if (_sp > XB_SPIN_CAP) { atomicAdd(&(bar)[XB_TMO], 1u); break; } } } } while (0)

struct XcdBarrier {
    unsigned* bar; unsigned x;
    volatile LAS unsigned* st;
};

__device__ __forceinline__ XcdBarrier xcd_barrier_post(unsigned* bar, volatile LAS unsigned* st) {
    XcdBarrier b; b.bar = bar; b.x = xb_xcc_id(); b.st = st;
    if (threadIdx.x == 0) (void)xb_add(&bar[XB_XCNT(b.x)], 1u);
    return b;
}
__device__ __forceinline__ void xcd_barrier_complete(unsigned* bar, unsigned x, unsigned& nloc, unsigned& nx) {
    const unsigned G = gridDim.x * gridDim.y * gridDim.z;
    unsigned sum, cnt, mine, sp = 0u;
    for (;;) {
        sum = 0u; cnt = 0u; mine = 0u;
#pragma unroll
        for (unsigned j = 0; j < 16; ++j) { const unsigned c = xb_ld(&bar[XB_XCNT(j)]); sum += c; cnt += (c > 0u) ? 1u : 0u; mine = (j == x) ? c : mine; }
        if (sum == G) break;
        __builtin_amdgcn_s_sleep(1);
        if ((++sp & 255u) == 0u) { if (xb_ld(&bar[XB_TMO])) break; if (sp > XB_SPIN_CAP) { atomicAdd(&bar[XB_TMO], 1u); break; } }
    }
    nloc = mine > 0u ? mine : 1u; nx = cnt > 0u ? cnt : 1u;
}

__device__ __forceinline__ void xcd_barrier(const XcdBarrier& b) {
    asm volatile("s_waitcnt vmcnt(0)" ::: "memory");
    __syncthreads();
    if (threadIdx.x == 0) {
        unsigned* bar = b.bar;
        __builtin_amdgcn_s_waitcnt(0);
        unsigned nloc = b.st[0], nx = b.st[1];
        if (nloc == 0u) { xcd_barrier_complete(bar, b.x, nloc, nx); b.st[0] = nloc; b.st[1] = nx; }
        const unsigned old = xb_add(&bar[XB_XSUB(b.x)], 1u);
        const unsigned gen = old / nloc;
        if (old + 1u == (gen + 1u) * nloc) {
            __builtin_amdgcn_fence(__ATOMIC_RELEASE, "agent");
            asm volatile("s_waitcnt vmcnt(0)" ::: "memory");
            const unsigned og = xb_add(&bar[XB_TOP], 1u);
            const unsigned tg = og / nx;
            if (og + 1u == (tg + 1u) * nx) xb_add(&bar[XB_TOPGEN], 1u);
            else XB_SPIN(xb_ld(&bar[XB_TOPGEN]) == tg, bar);
            __builtin_amdgcn_fence(__ATOMIC_ACQUIRE, "agent");
            xb_add(&bar[XB_XGEN(b.x)], 1u);
            asm volatile("s_waitcnt vmcnt(0)" ::: "memory");
        } else {
            XB_SPIN(xb_ld(&bar[XB_XGEN(b.x)]) == gen, bar);
            __builtin_amdgcn_fence(__ATOMIC_ACQUIRE, "agent");
            asm volatile("s_waitcnt vmcnt(0)" ::: "memory");
        }
    }
    __syncthreads();
}
struct Frame {
    LAS unsigned char* lds;
    int tid, lane, wave;
    int vcu, G;
    float* out;
    unsigned char* ws;
};
typedef float f32x2 __attribute__((ext_vector_type(2)));
__device__ __forceinline__ float wave_sum(float v) {
#pragma unroll
    for (int o = 1; o < 64; o <<= 1) v += __shfl_xor(v, o);
    return v;
}
__device__ __forceinline__ float bf2f(unsigned short v) { return __builtin_bit_cast(float, (unsigned)v << 16); }

__device__ __forceinline__ void tr_item(const float* W, int ldw, int nvalid, bf16* dst, int ldd, LAS float* scr, int lane) {
#pragma unroll 8
    for (int i = 0; i < 32; ++i) { const int kk = 2 * i + (lane >> 5), nn = lane & 31; scr[kk * 33 + nn] = nn < nvalid ? W[(size_t)kk * ldw + nn] : 0.f; }
    LDS_WAIT(); asm volatile("" ::: "memory");
    const int c = lane & 7;
#pragma unroll
    for (int j = 0; j < 4; ++j) { const int n = (lane >> 3) + 8 * j; const LAS float* s = scr + (8 * c) * 33 + n;
        v4u o; o.x = pk2(s[0 * 33], s[1 * 33]); o.y = pk2(s[2 * 33], s[3 * 33]); o.z = pk2(s[4 * 33], s[5 * 33]); o.w = pk2(s[6 * 33], s[7 * 33]);
        *(GAS v4u*)(dst + (size_t)n * ldd + 8 * c) = o; }
    LDS_WAIT(); asm volatile("" ::: "memory");
}
__device__ __forceinline__ void ln_row(const float* xrow, const float* g, const float* b, float* orow, bf16* xn, int lane) {
    const GAS f32x4* xr = (const GAS f32x4*)xrow + lane;
    f32x4 v[4]; float s = 0.f;
#pragma unroll
    for (int j = 0; j < 4; ++j) { v[j] = xr[64 * j]; s += (v[j].x + v[j].y) + (v[j].z + v[j].w); }
    const float mean = wave_sum(s) * (1.f / D); float s2 = 0.f;
#pragma unroll
    for (int j = 0; j < 4; ++j) { v[j] = v[j] - mean; s2 += (v[j].x * v[j].x + v[j].y * v[j].y) + (v[j].z * v[j].z + v[j].w * v[j].w); }
    const float rstd = 1.f / sqrtf(wave_sum(s2) * (1.f / D) + LN_EPS);
    GAS f32x4* o4 = (GAS f32x4*)orow + lane;
#pragma unroll
    for (int j = 0; j < 4; ++j) { const f32x4 gg = ((const GAS f32x4*)g)[lane + 64 * j], bb = ((const GAS f32x4*)b)[lane + 64 * j]; v[j] = v[j] * rstd * gg + bb; if (orow) o4[64 * j] = v[j]; }
    if (xn) { GAS unsigned long long* o8 = (GAS unsigned long long*)xn + lane;
#pragma unroll
        for (int j = 0; j < 4; ++j) o8[64 * j] = (unsigned long long)pk2(v[j].x, v[j].y) | ((unsigned long long)pk2(v[j].z, v[j].w) << 32); }
}
__device__ __forceinline__ void ln_row_b(const bf16* xrow, const float* g, const float* b, float* orow, bf16* xn, int lane) {
    float v[2][8]; float s = 0.f;
#pragma unroll
    for (int j = 0; j < 2; ++j) { const v4u w = *(const GAS v4u*)(xrow + 512 * j + 8 * lane);
        v[j][0] = __builtin_bit_cast(float, w.x << 16); v[j][1] = __builtin_bit_cast(float, w.x & 0xffff0000u); v[j][2] = __builtin_bit_cast(float, w.y << 16); v[j][3] = __builtin_bit_cast(float, w.y & 0xffff0000u);
        v[j][4] = __builtin_bit_cast(float, w.z << 16); v[j][5] = __builtin_bit_cast(float, w.z & 0xffff0000u); v[j][6] = __builtin_bit_cast(float, w.w << 16); v[j][7] = __builtin_bit_cast(float, w.w & 0xffff0000u);
#pragma unroll
        for (int e = 0; e < 8; ++e) s += v[j][e]; }
    const float mean = wave_sum(s) * (1.f / D); float s2 = 0.f;
#pragma unroll
    for (int j = 0; j < 2; ++j)
#pragma unroll
        for (int e = 0; e < 8; ++e) { v[j][e] -= mean; s2 += v[j][e] * v[j][e]; }
    const float rstd = 1.f / sqrtf(wave_sum(s2) * (1.f / D) + LN_EPS);
#pragma unroll
    for (int j = 0; j < 2; ++j) { const GAS f32x4* gp = (const GAS f32x4*)(g + 512 * j + 8 * lane); const GAS f32x4* bp = (const GAS f32x4*)(b + 512 * j + 8 * lane);
        const f32x4 g0 = gp[0], g1 = gp[1], b0 = bp[0], b1 = bp[1];
        f32x4 o0, o1;
#pragma unroll
        for (int e = 0; e < 4; ++e) { o0[e] = v[j][e] * rstd * g0[e] + b0[e]; o1[e] = v[j][4 + e] * rstd * g1[e] + b1[e]; }
        if (orow) { GAS f32x4* op = (GAS f32x4*)(orow + 512 * j + 8 * lane); op[0] = o0; op[1] = o1; }
        else { v4u w; w.x = pk2(o0[0], o0[1]); w.y = pk2(o0[2], o0[3]); w.z = pk2(o1[0], o1[1]); w.w = pk2(o1[2], o1[3]); *(GAS v4u*)(xn + 512 * j + 8 * lane) = w; } }
}
__device__ __forceinline__ void p0_prologue(Frame& F, const float* x_in, const float* emb_g, const float* emb_b, const float* w_in, const float* pool_w, const float* pool_scale,
                                            const float* w_uk, const float* w_uv, const float* w_o, const float* w_up, const float* w_down) {
    LAS float* scr = (LAS float*)(F.lds + L_MAIN + F.wave * 16384);
    const int gw = F.vcu * NWAVES + F.wave, NGW = F.G * NWAVES, lane = F.lane;
    bf16* WIN = (bf16*)(F.ws + WS_WIN); bf16* WO = (bf16*)(F.ws + WS_WO); bf16* WUP = (bf16*)(F.ws + WS_WUP); bf16* WDN = (bf16*)(F.ws + WS_WDN); bf16* WUK = (bf16*)(F.ws + WS_WUK);
    constexpr int I_IN = (D / 64) * 40, I_O = (512 / 64) * (D / 32), I_UP = (D / 64) * (FF / 32), I_DN = (FF / 64) * (D / 32), I_L = I_IN + I_O + I_UP + I_DN;
    for (int it = gw; it < NLAYER * I_L; it += NGW) {
        const int l = it / I_L; int r = it % I_L;
        if (r < I_IN) { const int kb = r / 40, nb = r % 40, n0 = 512 + 32 * nb;
            tr_item(w_in + (size_t)l * D * DIN + (size_t)(64 * kb) * DIN + n0, DIN, DIN - n0, WIN + (size_t)l * NP * D + (size_t)n0 * D + 64 * kb, D, scr, lane); continue; } r -= I_IN;
        if (r < I_O) { const int kb = r / 32, nb = r % 32;
            tr_item(w_o + (size_t)l * D * D + (size_t)(64 * kb) * D + 32 * nb, D, 32, WO + (size_t)l * D * KO + (size_t)(32 * nb) * KO + 64 * kb, KO, scr, lane); continue; } r -= I_O;
        if (r < I_UP) { const int kb = r / 128, nb = r % 128;
            tr_item(w_up + (size_t)l * D * FF + (size_t)(64 * kb) * FF + 32 * nb, FF, 32, WUP + (size_t)l * FF * D + (size_t)(32 * nb) * D + 64 * kb, D, scr, lane); continue; } r -= I_UP;
        { const int kb = r / 32, nb = r % 32;
            tr_item(w_down + (size_t)l * FF * D + (size_t)(64 * kb) * D + 32 * nb, D, 32, WDN + (size_t)l * D * FF + (size_t)(32 * nb) * FF + 64 * kb, FF, scr, lane); }
    }
    for (int it = gw; it < NLAYER * 4 * 128; it += NGW) {
        const int l = it >> 9, g = (it >> 7) & 3, k8 = it & 127;
        const float* wi = w_in + (size_t)l * D * DIN + (size_t)(8 * k8) * DIN + g * 128; const float* pw = pool_w + ((size_t)(l * 4 + g) * 128) * 128;
        float a0[8], a1[8];
#pragma unroll
        for (int kk = 0; kk < 8; ++kk) { a0[kk] = 0.f; a1[kk] = 0.f; }
#pragma unroll 8
        for (int c = 0; c < 128; ++c) { const float p0 = pw[c * 128 + lane], p1 = pw[c * 128 + 64 + lane];
#pragma unroll
            for (int kk = 0; kk < 8; ++kk) { const float a = wi[(size_t)kk * DIN + c]; a0[kk] += a * p0; a1[kk] += a * p1; } }
        const float s0 = pool_scale[l * 512 + g * 128 + lane], s1 = pool_scale[l * 512 + g * 128 + 64 + lane];
        v4u o; o.x = pk2(a0[0] * s0, a0[1] * s0); o.y = pk2(a0[2] * s0, a0[3] * s0); o.z = pk2(a0[4] * s0, a0[5] * s0); o.w = pk2(a0[6] * s0, a0[7] * s0);
        *(GAS v4u*)(WIN + (size_t)l * NP * D + (size_t)(g * 128 + lane) * D + 8 * k8) = o;
        o.x = pk2(a1[0] * s1, a1[1] * s1); o.y = pk2(a1[2] * s1, a1[3] * s1); o.z = pk2(a1[4] * s1, a1[5] * s1); o.w = pk2(a1[6] * s1, a1[7] * s1);
        *(GAS v4u*)(WIN + (size_t)l * NP * D + (size_t)(g * 128 + 64 + lane) * D + 8 * k8) = o;
    }
    for (int it = gw; it < NLAYER * 8 * 128; it += NGW) {
        const int l = it >> 10, h = (it >> 7) & 7, n8 = it & 127, nn = lane >> 4, cg = lane & 15;
        const float* uv = w_uv + (size_t)l * 128 * 512 + (size_t)(8 * cg) * 512 + h * 64; const float* wo = w_o + (size_t)l * D * D + (size_t)(512 + h * 64) * D;
#pragma unroll 1
        for (int st = 0; st < 2; ++st) { const int n = n8 * 8 + st * 4 + nn; float a[8];
#pragma unroll
            for (int i = 0; i < 8; ++i) a[i] = 0.f;
#pragma unroll 8
            for (int d = 0; d < 64; ++d) { const float w = wo[(size_t)d * D + n];
#pragma unroll
                for (int i = 0; i < 8; ++i) a[i] += uv[i * 512 + d] * w; }
            v4u o; o.x = pk2(a[0], a[1]); o.y = pk2(a[2], a[3]); o.z = pk2(a[4], a[5]); o.w = pk2(a[6], a[7]);
            *(GAS v4u*)(WO + (size_t)l * D * KO + (size_t)n * KO + 512 + h * 128 + 8 * cg) = o; }
    }
    for (int i = gw * 64 + lane; i < NLAYER * 128 * 512; i += NGW * 64) WUK[i] = (bf16)f2bf(w_uk[i] * 0.125f);
    bf16* XN = (bf16*)(F.ws + WS_XN);
    for (int m = gw; m < M; m += NGW) ln_row(x_in + (size_t)m * D, emb_g, emb_b, (float*)nullptr, XN + (size_t)m * D, lane);
}
__device__ __forceinline__ void ln_phase(Frame& F, const float* g, const float* b, bool last) {
    const int gw = F.vcu * NWAVES + F.wave, NGW = F.G * NWAVES; bf16* XN = (bf16*)(F.ws + WS_XN);
    for (int m = gw; m < M; m += NGW) ln_row_b(XN + (size_t)m * D, g, b, last ? F.out + (size_t)m * D : (float*)nullptr, XN + (size_t)m * D, F.lane);
}

namespace mixp {
typedef float f32x4 __attribute__((ext_vector_type(4)));
typedef short bf16x8 __attribute__((ext_vector_type(8)));
typedef unsigned short u16;
typedef unsigned short u16x4 __attribute__((ext_vector_type(4)));
typedef unsigned short u16x8 __attribute__((ext_vector_type(8)));
typedef unsigned u32x2 __attribute__((ext_vector_type(2)));
constexpr int CCAP = 1024;

__device__ __forceinline__ unsigned fkey(float f) { const unsigned b = __builtin_bit_cast(unsigned, f); const unsigned m = (unsigned)((int)b >> 31); return b ^ (m | 0x80000000u); }
__device__ __forceinline__ unsigned off_b(unsigned row, unsigned ch) { return 256u * row + 16u * (ch ^ (((row & 3u) << 2) | ((row >> 2) & 3u))); }
__device__ __forceinline__ unsigned cvtpk(float lo, float hi) { unsigned r; asm volatile("v_cvt_pk_bf16_f32 %0, %1, %2" : "=v"(r) : "v"(lo), "v"(hi)); return r; }

__device__ __forceinline__ void scan_hist(const LAS unsigned* hist, LAS unsigned* S, LAS unsigned* thr_out, LAS unsigned* need_out, int tid) {
    const int q = tid & 15, part = tid >> 4;
    unsigned sum = 0;
#pragma unroll 8
    for (int w = 0; w < 32; ++w) { const u32x2 v = *(const LAS u32x2*)(hist + (part * 32 + w) * 32 + 2 * q); sum += (v.x & 0xffffu) + (v.x >> 16) + (v.y & 0xffffu) + (v.y >> 16); }
    S[part * 16 + q] = sum;
    if (part == 0) { thr_out[q] = 0x7fffffffu; need_out[q] = 0u; }
    __syncthreads();
    const unsigned need = 256u;
    unsigned above = 0;
#pragma unroll 1
    for (int p2 = part + 1; p2 < 32; ++p2) above += S[p2 * 16 + q];
    if (above < need && above + sum >= need) {
#pragma unroll 1
        for (int w = 31; w >= 0; --w) { const u32x2 v = *(const LAS u32x2*)(hist + (part * 32 + w) * 32 + 2 * q); const unsigned hi = (v.x >> 16) + (v.y >> 16), lo = (v.x & 0xffffu) + (v.y & 0xffffu);
            if (above + hi >= need) { thr_out[q] = (unsigned)((part * 32 + w) * 2 + 1); need_out[q] = need - above; break; } above += hi;
            if (above + lo >= need) { thr_out[q] = (unsigned)((part * 32 + w) * 2); need_out[q] = need - above; break; } above += lo; }
    }
    __syncthreads();
}

template <int W, int NT>
__device__ __forceinline__ void pool_filter(const bf16* up, bf16* mp, int ts) {
    unsigned v[W - 1 + NT];
#pragma unroll
    for (int i = 0; i < W - 1 + NT; ++i) { const int t = ts - (W - 1) + i; v[i] = *(const unsigned*)(up + (size_t)(t < 0 ? 0 : t) * NP); if (t < 0) v[i] = 0u; }
    float s0 = 0.f, s1 = 0.f;
#pragma unroll
    for (int i = 0; i < W - 1; ++i) { s0 += bf2f((u16)(v[i] & 0xffff)); s1 += bf2f((u16)(v[i] >> 16)); }
#pragma unroll
    for (int i = 0; i < NT; ++i) { const int t = ts + i; const unsigned cv = v[W - 1 + i]; const float c0 = bf2f((u16)(cv & 0xffff)), c1 = bf2f((u16)(cv >> 16));
        s0 += c0; s1 += c1;
        const float inv = 1.0f / (float)(t + 1 < W ? t + 1 : W);
        *(unsigned*)(mp + (size_t)t * KO) = cvtpk(s0 * inv - c0, s1 * inv - c1);
        s0 -= bf2f((u16)(v[i] & 0xffff)); s1 -= bf2f((u16)(v[i] >> 16)); }
}

__device__ __forceinline__ void mix_unit(Frame& F, int layer, int b, int j) {
    int tid_ = F.tid; asm volatile("" : "+v"(tid_));
    const int tid = tid_, lane = tid & 63, wave = F.wave;
    const bf16* PROJ = (const bf16*)(F.ws + WS_PROJ); bf16* MIX = (bf16*)(F.ws + WS_MIX);
    const float* SS = (const float*)(F.ws + WS_SS) + (size_t)layer * M * 4;
    const bf16* WUK = (const bf16*)(F.ws + WS_WUK) + (size_t)layer * 128 * 512;
    LAS unsigned char* lds = F.lds;
    LAS unsigned* hist = (LAS unsigned*)(lds + L_MAIN);
    LAS unsigned* candu = (LAS unsigned*)(lds + L_MAIN);
    LAS u16* candi = (LAS u16*)(lds + L_MAIN + 65536);
    LAS u16* sel = (LAS u16*)(lds + L_SEL);
    LAS unsigned* bm = (LAS unsigned*)(lds + L_BM);
    LAS unsigned* Ssum = (LAS unsigned*)(lds + L_SS);
    LAS unsigned* cnt = (LAS unsigned*)(lds + L_CNT); LAS unsigned* ccnt = (LAS unsigned*)(lds + L_CCNT);
    LAS unsigned* thr1 = (LAS unsigned*)(lds + L_THR1); LAS unsigned* need1 = (LAS unsigned*)(lds + L_NEED1);
    const int brow = b * SEQ, t0 = 16 * j, tok0 = brow + t0;

    __syncthreads();
    for (int rep_ = 0; rep_ < ((DBG_REPM & 1) ? 2 : 1); ++rep_) {
        const int cp = tid & 255, th = tid >> 8, ch = 2 * cp, ts = t0 + 8 * th;
        const bf16* up = PROJ + (size_t)brow * NP + ch; bf16* mp = MIX + (size_t)brow * KO + ch;
        switch (wave & 3) { case 0: pool_filter<2, 8>(up, mp, ts); break; case 1: pool_filter<4, 8>(up, mp, ts); break; case 2: pool_filter<8, 8>(up, mp, ts); break; default: pool_filter<16, 8>(up, mp, ts); break; }
    }
    for (int rep_ = 0; rep_ < ((DBG_REPM & 2) ? 2 : 1); ++rep_) {
    if (rep_) __syncthreads();
    if (tid < 16) { cnt[tid] = 0u; ccnt[tid] = 0u; }
    if (j < 16) {
        for (int i = tid; i < 16 * 256; i += 512) sel[i] = (u16)(i & 255);
        __syncthreads();
        if (tid < 16) cnt[tid] = (unsigned)(t0 + tid + 1);
        __syncthreads();
    } else {
        const int n = lane & 15, g = lane >> 4, q = n, tq = t0 + q, hq = 2 * n + (g & 1);
        const bf16* qrow = PROJ + (size_t)(tok0 + q) * NP;
        bf16x8 Bq[8][2]; float wq[8];
#pragma unroll
        for (int h = 0; h < 8; ++h) { wq[h] = bf2f(qrow[COL_IW + h]);
#pragma unroll
            for (int s = 0; s < 2; ++s) Bq[h][s] = *(const bf16x8*)(qrow + COL_IQ + 64 * h + 32 * s + 8 * g); }
        bf16x8 Qh[2], Ql[2];
#pragma unroll
        for (int s = 0; s < 2; ++s) { float a[8];
#pragma unroll
            for (int e = 0; e < 8; ++e) { a[e] = 0.f;
#pragma unroll
                for (int h = 0; h < 8; ++h) a[e] += wq[h] * bf2f((u16)Bq[h][s][e]); }
            union { bf16x8 v; unsigned u[4]; } hi, lo;
#pragma unroll
            for (int e = 0; e < 4; ++e) { hi.u[e] = cvtpk(a[2 * e], a[2 * e + 1]);
                lo.u[e] = cvtpk(a[2 * e] - bf2f((u16)(hi.u[e] & 0xffff)), a[2 * e + 1] - bf2f((u16)(hi.u[e] >> 16))); }
            Qh[s] = hi.v; Ql[s] = lo.v; }
        const int ktmax = (t0 + 15) >> 5;
        { f32x4 z = (f32x4){0.f, 0.f, 0.f, 0.f}; for (int i = tid; i < 8192; i += 512) *(LAS f32x4*)(hist + 4 * i) = z; }
        __syncthreads();
        const bf16* kbase = PROJ + (size_t)(brow + n) * NP + COL_IK + 8 * g;
#pragma unroll 1
        for (int pass = 0; pass < 2; ++pass) {
            const unsigned b1 = pass ? thr1[q] : 0u;
            bf16x8 An[2][2];
            { const bf16* krow = kbase + (size_t)(32 * (wave <= ktmax ? wave : 0)) * NP;
#pragma unroll
                for (int kb = 0; kb < 2; ++kb)
#pragma unroll
                    for (int s = 0; s < 2; ++s) An[kb][s] = *(const bf16x8*)(krow + (size_t)(16 * kb) * NP + 32 * s); }
#pragma unroll 1
            for (int kt = wave; kt <= ktmax; kt += 8) {
                bf16x8 A[2][2];
#pragma unroll
                for (int kb = 0; kb < 2; ++kb)
#pragma unroll
                    for (int s = 0; s < 2; ++s) A[kb][s] = An[kb][s];
                { const bf16* krow = kbase + (size_t)(32 * (kt + 8 <= ktmax ? kt + 8 : kt)) * NP;
#pragma unroll
                    for (int kb = 0; kb < 2; ++kb)
#pragma unroll
                        for (int s = 0; s < 2; ++s) An[kb][s] = *(const bf16x8*)(krow + (size_t)(16 * kb) * NP + 32 * s); }
                f32x4 L[2];
#pragma unroll
                for (int kb = 0; kb < 2; ++kb) { L[kb] = (f32x4){0.f, 0.f, 0.f, 0.f};
#pragma unroll
                    for (int s = 0; s < 2; ++s) { L[kb] = __builtin_amdgcn_mfma_f32_16x16x32_bf16(A[kb][s], Qh[s], L[kb], 0, 0, 0); L[kb] = __builtin_amdgcn_mfma_f32_16x16x32_bf16(A[kb][s], Ql[s], L[kb], 0, 0, 0); } }
                float sc[8];
#pragma unroll
                for (int r = 0; r < 8; ++r) sc[r] = L[r >> 2][r & 3];
                f32x4 C0, C1;
#define MIX_HEAD_MFMA(h) do { C0 = (f32x4){0.f, 0.f, 0.f, 0.f}; C1 = (f32x4){0.f, 0.f, 0.f, 0.f}; \
                    C0 = __builtin_amdgcn_mfma_f32_16x16x32_bf16(A[0][0], Bq[h][0], C0, 0, 0, 0); C1 = __builtin_amdgcn_mfma_f32_16x16x32_bf16(A[1][0], Bq[h][0], C1, 0, 0, 0); \
                    C0 = __builtin_amdgcn_mfma_f32_16x16x32_bf16(A[0][1], Bq[h][1], C0, 0, 0, 0); C1 = __builtin_amdgcn_mfma_f32_16x16x32_bf16(A[1][1], Bq[h][1], C1, 0, 0, 0); } while (0)
#define MIX_HEAD_FMA(h) asm volatile("s_nop 6\n\tv_fma_f32 %0, %8, |%9|, %0\n\tv_fma_f32 %1, %8, |%10|, %1\n\tv_fma_f32 %2, %8, |%11|, %2\n\tv_fma_f32 %3, %8, |%12|, %3\n\t" \
                                     "v_fma_f32 %4, %8, |%13|, %4\n\tv_fma_f32 %5, %8, |%14|, %5\n\tv_fma_f32 %6, %8, |%15|, %6\n\tv_fma_f32 %7, %8, |%16|, %7" \
                                     : "+v"(sc[0]), "+v"(sc[1]), "+v"(sc[2]), "+v"(sc[3]), "+v"(sc[4]), "+v"(sc[5]), "+v"(sc[6]), "+v"(sc[7]) \
                                     : "v"(wq[h]), "v"(C0[0]), "v"(C0[1]), "v"(C0[2]), "v"(C0[3]), "v"(C1[0]), "v"(C1[1]), "v"(C1[2]), "v"(C1[3]))
#pragma unroll
                for (int h = 0; h < 8; ++h) { MIX_HEAD_MFMA(h); MIX_HEAD_FMA(h); }
#undef MIX_HEAD_MFMA
#undef MIX_HEAD_FMA
                const int key0 = 32 * kt + 4 * g;
                if (kt == ktmax) {
#pragma unroll
                    for (int r = 0; r < 8; ++r) if (key0 + 16 * (r >> 2) + (r & 3) > tq) sc[r] = -__builtin_inff();
                }
                unsigned u[8];
#pragma unroll
                for (int r = 0; r < 8; ++r) u[r] = fkey(sc[r]);
                if (pass == 0) {
#pragma unroll
                    for (int r = 0; r < 8; ++r) { const unsigned bin = u[r] >> 21; __hip_atomic_fetch_add(hist + (bin >> 1) * 32 + hq, 1u << ((bin & 1u) * 16u), __ATOMIC_RELAXED, __HIP_MEMORY_SCOPE_WORKGROUP); }
                } else {
                    unsigned selbits = 0u, cmask = 0u;
#pragma unroll
                    for (int r = 0; r < 8; ++r) { const unsigned bin = u[r] >> 21; if (bin > b1) selbits |= 1u << (4 * g + (r & 3) + 16 * (r >> 2)); else if (bin == b1) cmask |= 1u << r; }
                    selbits |= (unsigned)__shfl_xor((int)selbits, 16); selbits |= (unsigned)__shfl_xor((int)selbits, 32);
                    if (g == 0) bm[q * 128 + kt] = selbits;
                    if (cmask) {
                        unsigned slot = __hip_atomic_fetch_add(ccnt + q, (unsigned)__builtin_popcount(cmask), __ATOMIC_RELAXED, __HIP_MEMORY_SCOPE_WORKGROUP);
#pragma unroll
                        for (int r = 0; r < 8; ++r) if (cmask & (1u << r)) { if (slot < (unsigned)CCAP) { candu[q * CCAP + slot] = u[r]; candi[q * CCAP + slot] = (u16)(key0 + 16 * (r >> 2) + (r & 3)); } ++slot; }
                    }
                }
            }
            __syncthreads();
            if (pass == 0) scan_hist(hist, Ssum, thr1, need1, tid);
        }
        {
            LAS unsigned* wh = (LAS unsigned*)(lds + L_WH) + wave * 128;
#pragma unroll 1
            for (int qi = 0; qi < 2; ++qi) {
                const int q2 = 2 * wave + qi;
                int nc = __builtin_amdgcn_readfirstlane((int)ccnt[q2]); nc = nc < CCAP ? nc : CCAP;
                unsigned need = (unsigned)__builtin_amdgcn_readfirstlane((int)need1[q2]);
                unsigned base = (unsigned)__builtin_amdgcn_readfirstlane((int)cnt[q2]);
                unsigned cu[16];
#pragma unroll
                for (int k = 0; k < 16; ++k) { const int i = lane + 64 * k; cu[k] = i < nc ? (candu[q2 * CCAP + i] & 0x1fffffu) : 0x80000000u; }
                unsigned prefix = 0u;
#pragma unroll
                for (int lv = 0; lv < 3; ++lv) {
                    const int shift = 14 - 7 * lv;
                    *(LAS u32x2*)(wh + 2 * lane) = (u32x2){0u, 0u};
                    asm volatile("s_waitcnt lgkmcnt(0)" ::: "memory");
#pragma unroll
                    for (int k = 0; k < 16; ++k) if ((cu[k] >> (shift + 7)) == prefix) __hip_atomic_fetch_add(wh + ((cu[k] >> shift) & 127u), 1u, __ATOMIC_RELAXED, __HIP_MEMORY_SCOPE_WORKGROUP);
                    asm volatile("s_waitcnt lgkmcnt(0)" ::: "memory");
                    const u32x2 c01 = *(const LAS u32x2*)(wh + 2 * lane);
                    const unsigned tot = c01.x + c01.y; unsigned T = tot;
#pragma unroll
                    for (int d = 1; d < 64; d <<= 1) { const unsigned t = (unsigned)__shfl_down((int)T, d); T += (lane + d < 64) ? t : 0u; }
                    const unsigned long long mk = __ballot(T >= need);
                    const int ls = mk ? 63 - __builtin_clzll(mk) : 0;
                    const unsigned Ts = (unsigned)__builtin_amdgcn_readlane((int)T, ls), tots = (unsigned)__builtin_amdgcn_readlane((int)tot, ls), c1s = (unsigned)__builtin_amdgcn_readlane((int)c01.y, ls);
                    const unsigned excl = Ts - tots; unsigned bin;
                    if (excl + c1s >= need) { bin = 2u * ls + 1u; need -= excl; } else { bin = 2u * ls; need -= excl + c1s; }
                    prefix = (prefix << 7) | bin;
                }
                unsigned eqbits = 0u;
#pragma unroll
                for (int k = 0; k < 16; ++k) {
                    if (cu[k] == prefix) eqbits |= 1u << k;
                    if (cu[k] < 0x80000000u && cu[k] > prefix) { const unsigned id = candi[q2 * CCAP + lane + 64 * k]; __hip_atomic_fetch_or(bm + q2 * 128 + (id >> 5), 1u << (id & 31u), __ATOMIC_RELAXED, __HIP_MEMORY_SCOPE_WORKGROUP); }
                }
#pragma unroll 1
                for (unsigned it = 0; it < need; ++it) {
                    unsigned mymin = 0xffffu;
#pragma unroll
                    for (int k = 0; k < 16; ++k) if (eqbits & (1u << k)) { const unsigned id = candi[q2 * CCAP + lane + 64 * k]; mymin = id < mymin ? id : mymin; }
                    unsigned wmin = mymin;
#pragma unroll
                    for (int o = 1; o < 64; o <<= 1) { const unsigned t = (unsigned)__shfl_xor((int)wmin, o); wmin = t < wmin ? t : wmin; }
                    if (wmin == 0xffffu) break;
                    if (lane == 0) __hip_atomic_fetch_or(bm + q2 * 128 + (wmin >> 5), 1u << (wmin & 31u), __ATOMIC_RELAXED, __HIP_MEMORY_SCOPE_WORKGROUP);
#pragma unroll
                    for (int k = 0; k < 16; ++k) if ((eqbits & (1u << k)) && candi[q2 * CCAP + lane + 64 * k] == wmin) eqbits &= ~(1u << k);
                }
                asm volatile("s_waitcnt lgkmcnt(0)" ::: "memory");
                {
                    const int nw = ktmax + 1;
                    unsigned w0 = 2 * lane < nw ? bm[q2 * 128 + 2 * lane] : 0u, w1 = 2 * lane + 1 < nw ? bm[q2 * 128 + 2 * lane + 1] : 0u;
                    const unsigned c = (unsigned)(__builtin_popcount(w0) + __builtin_popcount(w1));
                    unsigned inc = c;
#pragma unroll
                    for (int d = 1; d < 64; d <<= 1) { const unsigned t = (unsigned)__shfl_up((int)inc, d); inc += (lane >= d) ? t : 0u; }
                    unsigned pos = inc - c;
                    while (w0) { const int bpos = __builtin_ctz(w0); w0 &= w0 - 1u; if (pos < 256u) sel[q2 * 256 + pos] = (u16)(64 * lane + bpos); ++pos; }
                    while (w1) { const int bpos = __builtin_ctz(w1); w1 &= w1 - 1u; if (pos < 256u) sel[q2 * 256 + pos] = (u16)(64 * lane + 32 + bpos); ++pos; }
                    const unsigned total = (unsigned)__builtin_amdgcn_readlane((int)inc, 63);
                    if (lane == 0) cnt[q2] = total < 256u ? total : 256u;
                }
            }
        }
        __syncthreads();
    }
    }
    LAS unsigned char* QL = lds + L_MAIN + 65536;
    const LAS float* gtab = (const LAS float*)(lds + L_G);
    {
        const int h = wave, n = lane & 15, g = lane >> 4;
        const bf16* qp = PROJ + (size_t)(tok0 + n) * NP + COL_Q + 64 * h + 8 * g;
        const bf16x8 q0 = *(const bf16x8*)qp, q1 = *(const bf16x8*)(qp + 32);
#pragma unroll
        for (int cb = 0; cb < 8; ++cb) {
            const bf16* wp = WUK + (size_t)(16 * cb + n) * 512 + 64 * h + 8 * g;
            f32x4 acc = (f32x4){0.f, 0.f, 0.f, 0.f};
            acc = __builtin_amdgcn_mfma_f32_16x16x32_bf16(*(const bf16x8*)wp, q0, acc, 0, 0, 0);
            acc = __builtin_amdgcn_mfma_f32_16x16x32_bf16(*(const bf16x8*)(wp + 32), q1, acc, 0, 0, 0);
            const f32x4 gg = *(const LAS f32x4*)(gtab + 16 * cb + 4 * g);
            u32x2 o; o.x = cvtpk(acc[0] * gg[0], acc[1] * gg[1]); o.y = cvtpk(acc[2] * gg[2], acc[3] * gg[3]);
            *(LAS u32x2*)(QL + n * 2048 + h * 256 + (16 * cb + 4 * g) * 2) = o;
        }
    }
    __syncthreads();
    for (int rep_ = 0; rep_ < ((DBG_REPM & 4) ? 2 : 1); ++rep_) {
        const int n = lane & 15, g = lane >> 4, hh = n & 7, m = n;
        const LAS float* lut = (const LAS float*)(lds + L_LUT);
        LAS float* rbuf = (LAS float*)(lds + L_RBUF) + wave * 32;
        LAS unsigned char* T = lds + L_MAIN + wave * 8192;
        const unsigned tbase = (unsigned)(size_t)T;
        const int kap0 = 8 * (m >> 2) + (m & 3), kap1 = kap0 + 4;
        unsigned tra[8][2];
#pragma unroll
        for (int cb = 0; cb < 8; ++cb)
#pragma unroll
            for (int t = 0; t < 2; ++t) tra[cb][t] = tbase + off_b((unsigned)(8 * g + 4 * t + ((lane & 15) >> 2)), (unsigned)(2 * cb + ((lane & 3) >> 1))) + 8u * (lane & 1);
        unsigned wra[2][4];
#pragma unroll
        for (int s = 0; s < 4; ++s) { wra[0][s] = off_b((unsigned)kap0, (unsigned)(4 * s + g)); wra[1][s] = off_b((unsigned)kap1, (unsigned)(4 * s + g)); }
#pragma unroll 1
        for (int qi = 0; qi < 2; ++qi) {
            const int q = wave * 2 + qi, tq = t0 + q, nv = __builtin_amdgcn_readfirstlane((int)cnt[q]), nch = (nv + 31) >> 5;
            bf16x8 Bq[4];
#pragma unroll
            for (int s = 0; s < 4; ++s) { Bq[s] = *(const LAS bf16x8*)(QL + q * 2048 + hh * 256 + (32 * s + 8 * g) * 2); if (n >= 8) Bq[s] = (bf16x8){0, 0, 0, 0, 0, 0, 0, 0}; }
            float mref = 0.f, lrun = 0.f; f32x4 O[8];
#pragma unroll
            for (int cb = 0; cb < 8; ++cb) O[cb] = (f32x4){0.f, 0.f, 0.f, 0.f};
            bf16x8 na0[4], na1[4], nb0[4], nb1[4]; float nss0 = 1.f, nss1 = 1.f, nsb0 = 1.f, nsb1 = 1.f;
#define MIX_GATHER(CH, D0, D1, DS0, DS1) do { const int p0_ = 32 * (CH) + kap0, p1_ = 32 * (CH) + kap1; \
                const int i0_ = p0_ < nv ? (int)sel[q * 256 + p0_] : 0, i1_ = p1_ < nv ? (int)sel[q * 256 + p1_] : 0; \
                const bf16* r0_ = PROJ + (size_t)(brow + i0_) * NP + COL_C + 8 * g; const bf16* r1_ = PROJ + (size_t)(brow + i1_) * NP + COL_C + 8 * g; \
                _Pragma("unroll") for (int s = 0; s < 4; ++s) { D0[s] = *(const bf16x8*)(r0_ + 32 * s); D1[s] = *(const bf16x8*)(r1_ + 32 * s); } \
                if (g == 0) { const f32x4 t0_ = *(const f32x4*)(SS + (size_t)(brow + i0_) * 4), t1_ = *(const f32x4*)(SS + (size_t)(brow + i1_) * 4); DS0 = (t0_[0] + t0_[1]) + (t0_[2] + t0_[3]); DS1 = (t1_[0] + t1_[1]) + (t1_[2] + t1_[3]); } } while (0)
            MIX_GATHER(0, na0, na1, nss0, nss1);
            if (nch > 1) MIX_GATHER(1, nb0, nb1, nsb0, nsb1);
#pragma unroll 1
            for (int ch = 0; ch < nch; ++ch) {
                bf16x8 a0[4], a1[4];
#pragma unroll
                for (int s = 0; s < 4; ++s) { a0[s] = na0[s]; a1[s] = na1[s]; na0[s] = nb0[s]; na1[s] = nb1[s]; }
                if (g == 0) { rbuf[kap0] = 1.0f / sqrtf(nss0 * (1.0f / 128.0f) + LN_EPS); rbuf[kap1] = 1.0f / sqrtf(nss1 * (1.0f / 128.0f) + LN_EPS); }
                nss0 = nsb0; nss1 = nsb1;
                if (ch + 2 < nch) MIX_GATHER(ch + 2, nb0, nb1, nsb0, nsb1);
                const u16x8 id8 = *(const LAS u16x8*)(sel + q * 256 + 32 * ch + 8 * g);
                float bias[8];
#pragma unroll
                for (int jx = 0; jx < 8; ++jx) { int dist = tq - (int)id8[jx]; dist = dist < 0 ? 0 : (dist > 128 ? 128 : dist); bias[jx] = lut[dist * 8 + hh]; }
                f32x4 S0 = (f32x4){0.f, 0.f, 0.f, 0.f}, S1 = (f32x4){0.f, 0.f, 0.f, 0.f};
#pragma unroll
                for (int s = 0; s < 4; ++s) { S0 = __builtin_amdgcn_mfma_f32_16x16x32_bf16(a0[s], Bq[s], S0, 0, 0, 0); S1 = __builtin_amdgcn_mfma_f32_16x16x32_bf16(a1[s], Bq[s], S1, 0, 0, 0); }
#pragma unroll
                for (int s = 0; s < 4; ++s) { *(LAS bf16x8*)(T + wra[0][s]) = a0[s]; *(LAS bf16x8*)(T + wra[1][s]) = a1[s]; }
                asm volatile("s_waitcnt lgkmcnt(0)" ::: "memory");
                const f32x4 ra = *(const LAS f32x4*)(rbuf + 8 * g), rb = *(const LAS f32x4*)(rbuf + 8 * g + 4);
                float lg[8], rr[8];
#pragma unroll
                for (int jx = 0; jx < 8; ++jx) { rr[jx] = jx < 4 ? ra[jx] : rb[jx - 4];
                    const int pos = 32 * ch + 8 * g + jx; const float sv = jx < 4 ? S0[jx] : S1[jx - 4];
                    lg[jx] = pos < nv ? sv * rr[jx] + bias[jx] : -1e30f; }
                if (ch == 0) {
                    float cm = fmaxf(fmaxf(fmaxf(lg[0], lg[1]), fmaxf(lg[2], lg[3])), fmaxf(fmaxf(lg[4], lg[5]), fmaxf(lg[6], lg[7])));
                    cm = fmaxf(cm, __shfl_xor(cm, 16)); cm = fmaxf(cm, __shfl_xor(cm, 32)); mref = cm; }
                float ps = 0.f, pp[8];
#pragma unroll
                for (int jx = 0; jx < 8; ++jx) { const float p = __builtin_amdgcn_exp2f(fminf((lg[jx] - mref) * 1.44269504f, 100.f)); ps += p; pp[jx] = p * rr[jx]; }
                lrun += ps;
                union { bf16x8 v; unsigned u[4]; } P;
                P.u[0] = cvtpk(pp[0], pp[1]); P.u[1] = cvtpk(pp[2], pp[3]); P.u[2] = cvtpk(pp[4], pp[5]); P.u[3] = cvtpk(pp[6], pp[7]);
#pragma unroll
                for (int c4 = 0; c4 < 2; ++c4) {
                    u16x4 x0, x1, x2, x3, x4, x5, x6, x7;
                    asm volatile("ds_read_b64_tr_b16 %0, %8\n\tds_read_b64_tr_b16 %1, %9\n\tds_read_b64_tr_b16 %2, %10\n\tds_read_b64_tr_b16 %3, %11\n\t"
                                 "ds_read_b64_tr_b16 %4, %12\n\tds_read_b64_tr_b16 %5, %13\n\tds_read_b64_tr_b16 %6, %14\n\tds_read_b64_tr_b16 %7, %15\n\ts_waitcnt lgkmcnt(0)"
                                 : "=&v"(x0), "=&v"(x1), "=&v"(x2), "=&v"(x3), "=&v"(x4), "=&v"(x5), "=&v"(x6), "=&v"(x7)
                                 : "v"(tra[4 * c4 + 0][0]), "v"(tra[4 * c4 + 0][1]), "v"(tra[4 * c4 + 1][0]), "v"(tra[4 * c4 + 1][1]),
                                   "v"(tra[4 * c4 + 2][0]), "v"(tra[4 * c4 + 2][1]), "v"(tra[4 * c4 + 3][0]), "v"(tra[4 * c4 + 3][1]) : "memory");
                    union { bf16x8 v; u16x4 h[2]; } A0, A1, A2, A3;
                    A0.h[0] = x0; A0.h[1] = x1; A1.h[0] = x2; A1.h[1] = x3; A2.h[0] = x4; A2.h[1] = x5; A3.h[0] = x6; A3.h[1] = x7;
                    O[4 * c4 + 0] = __builtin_amdgcn_mfma_f32_16x16x32_bf16(A0.v, P.v, O[4 * c4 + 0], 0, 0, 0);
                    O[4 * c4 + 1] = __builtin_amdgcn_mfma_f32_16x16x32_bf16(A1.v, P.v, O[4 * c4 + 1], 0, 0, 0);
                    O[4 * c4 + 2] = __builtin_amdgcn_mfma_f32_16x16x32_bf16(A2.v, P.v, O[4 * c4 + 2], 0, 0, 0);
                    O[4 * c4 + 3] = __builtin_amdgcn_mfma_f32_16x16x32_bf16(A3.v, P.v, O[4 * c4 + 3], 0, 0, 0);
                }
            }
            float lt = lrun; lt += __shfl_xor(lt, 16); lt += __shfl_xor(lt, 32);
            const float inv = 1.0f / lt;
            if (n < 8) {
                bf16* op = MIX + (size_t)(tok0 + q) * KO + 512 + n * 128 + 4 * g;
#pragma unroll
                for (int cb = 0; cb < 8; ++cb) { const f32x4 gg = *(const LAS f32x4*)(gtab + 16 * cb + 4 * g);
                    u32x2 o; o.x = cvtpk(O[cb][0] * inv * gg[0], O[cb][1] * inv * gg[1]); o.y = cvtpk(O[cb][2] * inv * gg[2], O[cb][3] * inv * gg[3]);
                    *(u32x2*)(op + 16 * cb) = o; }
            }
        }
    }
}

#undef MIX_GATHER
__device__ __forceinline__ void mix_phase(Frame& F, int layer, const float* rel_bias, const float* kvg) {
    LAS float* lut = (LAS float*)(F.lds + L_LUT); LAS float* gtab = (LAS float*)(F.lds + L_G);
    for (int i = F.tid; i < 129 * 8; i += 512) { const int nd = i >> 3, h = i & 7; int bk;
        if (nd < 16) bk = nd; else { bk = 16 + (int)(logf((float)nd / 16.0f) / logf(8.0f) * 16.0f); bk = bk > 31 ? 31 : bk; }
        lut[i] = rel_bias[bk * 8 + h]; }
    if (F.tid < 128) gtab[F.tid] = kvg[F.tid];
    __syncthreads();
#pragma unroll 1
    for (int it = 2 * F.vcu; it < 2048; ++it) { const int p = it >> 1, b = p >> 7, jj = p & 127; mix_unit(F, layer, b, (it & 1) ? 255 - jj : jj); if (it & 1) it += 2 * F.G - 2; }
    __syncthreads();
}
}

struct Args { const float* in[17]; float* out; unsigned char* ws; int ph_lo, ph_hi; };
static_assert(sizeof(Args) == 17 * 8 + 8 + 8 + 8, "Args has no padding");
#if MK_PER_PHASE
#define GRID_BAR() do { } while (0)
#else
#define GRID_BAR() xcd_barrier(bar)
#endif
#define IN(k) (lo <= (k) && (k) < hi)
#define SEAM(k) do { if (IN((k) + 1)) GRID_BAR(); } while (0)
template <int L>
__device__ __forceinline__ void run_layer(Frame& F, const XcdBarrier& bar, const int lo, const int hi, const float* rel_bias, const float* kvg, const float* ln1g, const float* ln1b, const float* ln2g, const float* ln2b) {
    constexpr int pb = 1 + 7 * L;
    bf16* XN = (bf16*)(F.ws + WS_XN); bf16* PROJ = (bf16*)(F.ws + WS_PROJ); bf16* MIX = (bf16*)(F.ws + WS_MIX); bf16* HB = (bf16*)(F.ws + WS_H);
#ifndef DBG_NO_GEMM
    if (IN(pb + 0)) {
        pg8::Gemm g{XN, (const bf16*)(F.ws + WS_WIN) + (size_t)L * NP * D, M, NP, D}; pg8::StaticOrder S; S.init(M, NP, F.G, (int)blockIdx.x);
        pg8::EpiProj E{PROJ, NP, (float*)(F.ws + WS_SS) + (size_t)L * M * 4};
        pg8::gemm_phase<pg8::EpiProj, pg8::StaticOrder, PG8_ALIGN, PG8_SP2>(F.lds + L_MAIN, g, S, E);
        SEAM(pb + 0);
    }
#endif
#ifndef DBG_NO_MIX
    if (IN(pb + 1)) {
#if (DBG_REP & 2)
        mixp::mix_phase(F, L, rel_bias, kvg); GRID_BAR();
#endif
        mixp::mix_phase(F, L, rel_bias, kvg); SEAM(pb + 1); }
#endif
#ifndef DBG_NO_GEMM
    if (IN(pb + 2)) {
        pg8::Gemm g{MIX, (const bf16*)(F.ws + WS_WO) + (size_t)L * D * KO, M, D, KO}; pg8::StaticOrder S; S.init(M, D, F.G, (int)blockIdx.x);
        pg8::EpiRes E{XN, D, ALPHA};
        pg8::gemm_phase<pg8::EpiRes, pg8::StaticOrder, PG8_ALIGN, PG8_SP2>(F.lds + L_MAIN, g, S, E);
        SEAM(pb + 2);
    }
    if (IN(pb + 3)) { ln_phase(F, ln1g, ln1b, false); SEAM(pb + 3); }
    if (IN(pb + 4)) {
        pg8::Gemm g{XN, (const bf16*)(F.ws + WS_WUP) + (size_t)L * FF * D, M, FF, D}; pg8::StaticOrder S; S.init(M, FF, F.G, (int)blockIdx.x);
        pg8::EpiRelu2 E{HB, FF};
#if (DBG_REP & 4)
        pg8::gemm_phase<pg8::EpiRelu2, pg8::StaticOrder, PG8_ALIGN, PG8_SP2>(F.lds + L_MAIN, g, S, E); GRID_BAR();
#endif
        pg8::gemm_phase<pg8::EpiRelu2, pg8::StaticOrder, PG8_ALIGN, PG8_SP2>(F.lds + L_MAIN, g, S, E);
        SEAM(pb + 4);
    }
    if (IN(pb + 5)) {
        pg8::Gemm g{HB, (const bf16*)(F.ws + WS_WDN) + (size_t)L * D * FF, M, D, FF}; pg8::StaticOrder S; S.init(M, D, F.G, (int)blockIdx.x);
        pg8::EpiRes E{XN, D, ALPHA};
        pg8::gemm_phase<pg8::EpiRes, pg8::StaticOrder, PG8_ALIGN, PG8_SP2>(F.lds + L_MAIN, g, S, E);
        SEAM(pb + 5);
    }
#endif
    if (IN(pb + 6)) { ln_phase(F, ln2g, ln2b, L + 1 == NLAYER); if (L + 1 < NLAYER) SEAM(pb + 6); }
}
__global__ void __launch_bounds__(NWAVES * 64, 2) hymba_fwd(Args args) {
    extern __shared__ __attribute__((aligned(16))) unsigned char lds[];
    Frame F;
    F.lds = (LAS unsigned char*)lds;
    F.tid = threadIdx.x; F.lane = F.tid & 63; F.wave = __builtin_amdgcn_readfirstlane(F.tid >> 6);
    F.G = gridDim.x; { const int bx = blockIdx.x; F.vcu = (F.G % 8 == 0) ? (bx % 8) * (F.G / 8) + bx / 8 : bx; }
    F.out = args.out; F.ws = args.ws;
    volatile LAS unsigned* MISC = (volatile LAS unsigned*)(F.lds + L_MISC);
    if (F.tid < 32) MISC[F.tid] = 0u;
    __syncthreads();
    XcdBarrier bar; bar.bar = (unsigned*)(F.ws + WS_CTL) + CW_BAR; bar.x = 0; bar.st = nullptr;
#if !MK_PER_PHASE
    bar = xcd_barrier_post((unsigned*)(F.ws + WS_CTL) + CW_BAR, MISC + 8);
#endif
    const int lo = args.ph_lo, hi = args.ph_hi;
#ifndef DBG_NO_PRO
    if (IN(0)) {
#if (DBG_REP & 1)
        p0_prologue(F, args.in[0], args.in[1], args.in[2], args.in[4], args.in[5], args.in[6], args.in[8], args.in[9], args.in[10], args.in[13], args.in[14]); GRID_BAR();
#endif
        p0_prologue(F, args.in[0], args.in[1], args.in[2], args.in[4], args.in[5], args.in[6], args.in[8], args.in[9], args.in[10], args.in[13], args.in[14]); SEAM(0); }
#endif
    run_layer<0>(F, bar, lo, hi, args.in[3], args.in[7], args.in[11], args.in[12], args.in[15], args.in[16]);
    run_layer<1>(F, bar, lo, hi, args.in[3], args.in[7] + 128, args.in[11] + D, args.in[12] + D, args.in[15] + D, args.in[16] + D);
}
#undef IN
#undef SEAM
#undef GRID_BAR

extern "C" void kernel_launch(void* const* d_in, const int* in_sizes, int n_in, void* d_out, int out_size, void* d_ws, size_t ws_size, hipStream_t stream) {
    static int grid = 0;
    if (grid == 0) {
        if (n_in != 17 || in_sizes[0] != M * D || out_size != M * D || ws_size < WS_END) { fprintf(stderr, "kernel_launch: unexpected shapes (n_in %d, in0 %d, out %d, ws %zu)\n", n_in, n_in > 0 ? in_sizes[0] : -1, out_size, ws_size); grid = -1; return; }
        int dev = 0, cus = 0, per_cu = 0;
        if (hipGetDevice(&dev) != hipSuccess || hipDeviceGetAttribute(&cus, hipDeviceAttributeMultiprocessorCount, dev) != hipSuccess) { grid = -1; return; }
        if (hipFuncSetAttribute((const void*)hymba_fwd, hipFuncAttributeMaxDynamicSharedMemorySize, LDS_BYTES) != hipSuccess) { fprintf(stderr, "kernel_launch: hipFuncSetAttribute failed\n"); grid = -1; return; }
        if (hipOccupancyMaxActiveBlocksPerMultiprocessor(&per_cu, (const void*)hymba_fwd, NWAVES * 64, LDS_BYTES) != hipSuccess || per_cu < 1) { fprintf(stderr, "kernel_launch: occupancy query says %d blocks per CU\n", per_cu); per_cu = 1; }
        (void)hipGetLastError();
        grid = cus;
    }
    if (grid < 0) return;
    (void)hipMemsetAsync((char*)d_ws + WS_CTL, 0, CTL_ZERO_BYTES, stream);
    Args a{};
    for (int i = 0; i < 17; ++i) a.in[i] = (const float*)d_in[i];
    a.out = (float*)d_out; a.ws = (unsigned char*)d_ws;
#if MK_PER_PHASE
    for (int p = 0; p < N_PHASES; ++p) { a.ph_lo = p; a.ph_hi = p + 1; hipLaunchKernelGGL(hymba_fwd, dim3(grid), dim3(NWAVES * 64), LDS_BYTES, stream, a); }
#else
    a.ph_lo = 0; a.ph_hi = N_PHASES;
    hipLaunchKernelGGL(hymba_fwd, dim3(grid), dim3(NWAVES * 64), LDS_BYTES, stream, a);
#endif
    const hipError_t le = hipPeekAtLastError();
    if (le != hipSuccess) fprintf(stderr, "kernel_launch: launch failed: %s\n", hipGetErrorName(le));
}
```

```cpp
#define MK_PER_PHASE 0
#ifndef DBG_PMASK
#define DBG_PMASK 31
#endif
#ifndef DBG_SKIP
#define DBG_SKIP 0
#endif
#ifndef DBG_REPM
#define DBG_REPM 0
#endif
#ifndef DBG_REP
#define DBG_REP 0
#endif
#include <hip/hip_runtime.h>
#include <cstdio>
#include <cstdint>
namespace pg8 {
#define PG8_LAS __attribute__((address_space(3)))
typedef unsigned short bf16_t;
typedef short bf16x8 __attribute__((ext_vector_type(8)));
typedef float f32x4 __attribute__((ext_vector_type(4)));
typedef unsigned u32x4 __attribute__((ext_vector_type(4)));
constexpr int BM = 256, BK = 64, HALF = 128, HTB = HALF * BK * 2  , STAGE_BYTES = 8 * HTB, NXCD = 8, WGM = 8;

__host__ __device__ __forceinline__ int lds_byte(int r, int c) { const int st = (r >> 4) * 2 + (c >> 5), rr = r & 15, cc = c & 31, ob = rr * 64 + cc * 2; return st * 1024 + (ob ^ (((ob >> 9) & 1) << 5)); }
__host__ __device__ __forceinline__ void stage_rc(int b, int& R, int& C) { const int st = b / 1024, sb = b % 1024, swz = sb ^ (((sb >> 9) & 1) << 5); R = (st >> 1) * 16 + swz / 64; C = (st & 1) * 32 + (swz % 64) / 2; }
__host__ __device__ __forceinline__ int perm32(int rho) { const int n = rho >> 4, i = rho & 15; return 8 * (i >> 2) + 4 * n + (i & 3); }

struct Unit { int pm, pn; };
struct Gemm { const bf16_t* A; const bf16_t* Bt; int M, N, K; };

struct StaticOrder {
    int nM, nN, nwg, G, c;
    __host__ __device__ void init(int M, int N, int G_, int c_) { nM = M / BM; nN = N / BM; nwg = nM * nN; G = G_; c = c_; }
    __host__ __device__ bool next(int i, Unit& u) const {
        const long L = (long)i * G + c; if (L >= nwg) return false;
        int wgid = (int)L; { const int q = nwg / NXCD, r = nwg % NXCD, xcd = wgid % NXCD, off = wgid / NXCD; wgid = (xcd < r ? xcd * (q + 1) : r * (q + 1) + (xcd - r) * q) + off; }
        const int nig = WGM * nN, gid = wgid / nig, fm = gid * WGM, gsz = (nM - fm) < WGM ? (nM - fm) : WGM;
        u.pm = fm + ((wgid % nig) % gsz); u.pn = (wgid % nig) / gsz; return true;
    }
    __device__ __forceinline__ void a_ready(const Unit&) const {}
    __device__ __forceinline__ void done(const Unit&) const {}
};

__device__ __forceinline__ unsigned cvt_pk_bf16(float lo, float hi) { unsigned r; asm volatile("v_cvt_pk_bf16_f32 %0, %1, %2" : "=v"(r) : "v"(lo), "v"(hi)); return r; }

struct EpiProj {
    static constexpr bool PERM = true, AFTER_DRAIN = false;
    bf16_t* O; int ldc;
    __device__ __forceinline__ void operator()(const f32x4 (&acc)[2][2][4][2], const Unit& u, int wr, int wc, int fr, int fq) const {
        const int row0 = u.pm * BM + wr * 64 + fr, col0 = u.pn * BM + wc * 32 + 8 * fq;
#pragma unroll
        for (int ai = 0; ai < 2; ++ai)
#pragma unroll
            for (int m = 0; m < 4; ++m) { bf16_t* rowp = O + (size_t)(row0 + ai * HALF + m * 16) * ldc + col0;
#pragma unroll
                for (int bj = 0; bj < 2; ++bj) { const f32x4 v0 = acc[ai][bj][m][0], v1 = acc[ai][bj][m][1];
                    u32x4 w; w.x = cvt_pk_bf16(v0[0], v0[1]); w.y = cvt_pk_bf16(v0[2], v0[3]); w.z = cvt_pk_bf16(v1[0], v1[1]); w.w = cvt_pk_bf16(v1[2], v1[3]);
                    *(u32x4*)(rowp + bj * HALF) = w; } }
    }
};
struct EpiRes {
    static constexpr bool PERM = true, AFTER_DRAIN = false;
    bf16_t* X; int ldc; float alpha;
    __device__ __forceinline__ void operator()(const f32x4 (&acc)[2][2][4][2], const Unit& u, int wr, int wc, int fr, int fq) const {
        const int row0 = u.pm * BM + wr * 64 + fr, col0 = u.pn * BM + wc * 32 + 8 * fq;
#pragma unroll
        for (int ai = 0; ai < 2; ++ai)
#pragma unroll
            for (int m = 0; m < 4; ++m) { bf16_t* rowp = X + (size_t)(row0 + ai * HALF + m * 16) * ldc + col0;
                u32x4 xin[2];
#pragma unroll
                for (int bj = 0; bj < 2; ++bj) xin[bj] = *(const u32x4*)(rowp + bj * HALF);
#pragma unroll
                for (int bj = 0; bj < 2; ++bj) { const f32x4 v0 = acc[ai][bj][m][0], v1 = acc[ai][bj][m][1]; const u32x4 x = xin[bj];
#define PG8_LO(w) __builtin_bit_cast(float, (w) << 16)
#define PG8_HI(w) __builtin_bit_cast(float, (w) & 0xffff0000u)
                    u32x4 w; w.x = cvt_pk_bf16(PG8_LO(x.x) * alpha + v0[0], PG8_HI(x.x) * alpha + v0[1]); w.y = cvt_pk_bf16(PG8_LO(x.y) * alpha + v0[2], PG8_HI(x.y) * alpha + v0[3]);
                    w.z = cvt_pk_bf16(PG8_LO(x.z) * alpha + v1[0], PG8_HI(x.z) * alpha + v1[1]); w.w = cvt_pk_bf16(PG8_LO(x.w) * alpha + v1[2], PG8_HI(x.w) * alpha + v1[3]);
#undef PG8_LO
#undef PG8_HI
                    *(u32x4*)(rowp + bj * HALF) = w; }
                asm volatile("" ::: "memory"); }
    }
};
struct EpiRelu2 {
    static constexpr bool PERM = true, AFTER_DRAIN = false;
    bf16_t* O; int ldc;
    __device__ __forceinline__ void operator()(const f32x4 (&acc)[2][2][4][2], const Unit& u, int wr, int wc, int fr, int fq) const {
        const int row0 = u.pm * BM + wr * 64 + fr, col0 = u.pn * BM + wc * 32 + 8 * fq;
#pragma unroll
        for (int ai = 0; ai < 2; ++ai)
#pragma unroll
            for (int m = 0; m < 4; ++m) { bf16_t* rowp = O + (size_t)(row0 + ai * HALF + m * 16) * ldc + col0;
#pragma unroll
                for (int bj = 0; bj < 2; ++bj) { f32x4 v0 = acc[ai][bj][m][0], v1 = acc[ai][bj][m][1];
#pragma unroll
                    for (int j = 0; j < 4; ++j) { const float a = fmaxf(v0[j], 0.f), b = fmaxf(v1[j], 0.f); v0[j] = a * a; v1[j] = b * b; }
                    u32x4 w; w.x = cvt_pk_bf16(v0[0], v0[1]); w.y = cvt_pk_bf16(v0[2], v0[3]); w.z = cvt_pk_bf16(v1[0], v1[1]); w.w = cvt_pk_bf16(v1[2], v1[3]);
                    *(u32x4*)(rowp + bj * HALF) = w; } }
    }
};

template <class Epi, class Sched, bool ALIGN_EPI = false, bool SP2 = false>
__device__ __forceinline__ void gemm_phase(PG8_LAS unsigned char* lds, const Gemm g, const Sched& S, const Epi& E) {
    const int tid = threadIdx.x, wid = __builtin_amdgcn_readfirstlane(tid >> 6), lane = tid & 63, wr = wid >> 2, wc = wid & 3, fr = lane & 15, fq = lane >> 4;
    const int K = g.K, nt = K / BK;
    unsigned voffA[2], voffB[2];
#pragma unroll
    for (int i = 0; i < 2; ++i) { int R, C; stage_rc(tid * 16 + i * 8192, R, C); const int Rb = Epi::PERM ? ((R & ~31) + perm32(R & 31)) : R;
        voffA[i] = (unsigned)(R * K + C) * 2u; voffB[i] = (unsigned)(Rb * K + C) * 2u; }
    const size_t kstep = (size_t)(BK * 2);
    const size_t hstep = (size_t)HALF * K * 2;
    const size_t tstep = 2 * hstep;
    const unsigned ldsw = (unsigned)wid * 1024u;
    const int aoff = lds_byte(wr * 64 + fr, fq * 8), boff = lds_byte(wc * 32 + fr, fq * 8);
#define PG8_SA(b, h) (((b) * 2 + (h)) * HTB)
#define PG8_SB(b, h) ((4 + (b) * 2 + (h)) * HTB)
#define PG8_STAGE(bufoff, gbase, voff) do { _Pragma("unroll") for (int _i = 0; _i < 2; ++_i) \
        __builtin_amdgcn_global_load_lds((const unsigned*)((const char*)(gbase) + (voff)[_i]), (PG8_LAS unsigned*)(lds + (bufoff) + ldsw + _i * 8192), 16, 0, 0); } while (0)
#define PG8_LDA(dst, b, h) do { _Pragma("unroll") for (int m = 0; m < 4; ++m) _Pragma("unroll") for (int k = 0; k < 2; ++k) dst[m][k] = *(const PG8_LAS bf16x8*)(lds + PG8_SA(b, h) + aoff + m * 2048 + k * 1024); } while (0)
#define PG8_LDB(dst, b, h) do { _Pragma("unroll") for (int n = 0; n < 2; ++n) _Pragma("unroll") for (int k = 0; k < 2; ++k) dst[n][k] = *(const PG8_LAS bf16x8*)(lds + PG8_SB(b, h) + boff + n * 2048 + k * 1024); } while (0)
#define PG8_MMA(ai, bj, At, Bt) do { __builtin_amdgcn_s_setprio(1); _Pragma("unroll") for (int m = 0; m < 4; ++m) _Pragma("unroll") for (int n = 0; n < 2; ++n) _Pragma("unroll") for (int k = 0; k < 2; ++k) \
        acc[ai][bj][m][n] = __builtin_amdgcn_mfma_f32_16x16x32_bf16(Bt[n][k], At[m][k], acc[ai][bj][m][n], 0, 0, 0); __builtin_amdgcn_s_setprio(0); } while (0)
#define PG8_WAIT_V(n) asm volatile("s_waitcnt vmcnt(" #n ")" ::: "memory")
#define PG8_WAIT_L(n) asm volatile("s_waitcnt lgkmcnt(" #n ")" ::: "memory")
#define PG8_BAR __builtin_amdgcn_s_barrier()
#define PG8_SCHED __builtin_amdgcn_sched_barrier(0)
    Unit cur, nxt; int ui = 0;
    if (!S.next(0, cur)) return;
    f32x4 acc[2][2][4][2];
#pragma unroll
    for (int a = 0; a < 2; ++a)
#pragma unroll
        for (int b = 0; b < 2; ++b)
#pragma unroll
            for (int m = 0; m < 4; ++m)
#pragma unroll
                for (int n = 0; n < 2; ++n) acc[a][b][m][n] = (f32x4){0.f, 0.f, 0.f, 0.f};
    bf16x8 At[4][2], B0[2][2], B1[2][2];
    const char* cA = (const char*)g.A + (size_t)cur.pm * tstep; const char* cB = (const char*)g.Bt + (size_t)cur.pn * tstep;
    S.a_ready(cur);
    if constexpr (SP2) {
        PG8_STAGE(PG8_SB(0, 0), cB, voffB); PG8_STAGE(PG8_SB(0, 1), cB + hstep, voffB); PG8_STAGE(PG8_SA(0, 0), cA, voffA); PG8_STAGE(PG8_SA(0, 1), cA + hstep, voffA);
        if (wr == 1) PG8_BAR;
        PG8_WAIT_V(2); PG8_BAR;
        PG8_STAGE(PG8_SB(1, 0), cB + kstep, voffB); PG8_STAGE(PG8_SA(1, 0), cA + kstep, voffA); PG8_STAGE(PG8_SB(1, 1), cB + hstep + kstep, voffB);
        PG8_WAIT_V(6); PG8_BAR;
    } else {
        PG8_STAGE(PG8_SB(0, 0), cB, voffB); PG8_STAGE(PG8_SA(0, 0), cA, voffA); PG8_STAGE(PG8_SB(0, 1), cB + hstep, voffB); PG8_STAGE(PG8_SA(0, 1), cA + hstep, voffA);
        if (wr == 1) PG8_BAR;
        PG8_WAIT_V(4); PG8_BAR;
        PG8_STAGE(PG8_SB(1, 0), cB + kstep, voffB); PG8_STAGE(PG8_SA(1, 0), cA + kstep, voffA); PG8_STAGE(PG8_SB(1, 1), cB + hstep + kstep, voffB);
        PG8_WAIT_V(6); PG8_BAR;
    }
    for (;;) {
        const bool has_next = S.next(ui + 1, nxt);
        const char* nA = has_next ? (const char*)g.A + (size_t)nxt.pm * tstep : cA; const char* nB = has_next ? (const char*)g.Bt + (size_t)nxt.pn * tstep : cB;
        for (int t = 0; t < nt; t += 2) {
            const bool last = (t == nt - 2);
            const char* a1 = cA + (size_t)(t + 1) * kstep;
            const char* a2 = last ? nA : cA + (size_t)(t + 2) * kstep; const char* b2 = last ? nB : cB + (size_t)(t + 2) * kstep;
            const char* a3 = a2 + kstep; const char* b3 = b2 + kstep;
            if (last && has_next) S.a_ready(nxt);
            if constexpr (SP2) {
            PG8_LDB(B0, 0, 0); PG8_LDB(B1, 0, 1); PG8_SCHED; PG8_LDA(At, 0, 0); PG8_STAGE(PG8_SA(1, 1), a1 + hstep, voffA);
            PG8_WAIT_V(8); PG8_WAIT_L(0); PG8_BAR; PG8_MMA(0, 0, At, B0); PG8_MMA(0, 1, At, B1); PG8_BAR; PG8_SCHED;
            PG8_LDA(At, 0, 1); PG8_STAGE(PG8_SB(0, 0), b2, voffB); PG8_STAGE(PG8_SB(0, 1), b2 + hstep, voffB); PG8_STAGE(PG8_SA(0, 0), a2, voffA);
            PG8_WAIT_V(8); PG8_WAIT_L(0); PG8_BAR; PG8_MMA(1, 0, At, B0); PG8_MMA(1, 1, At, B1); PG8_BAR; PG8_SCHED;
            PG8_LDB(B0, 1, 0); PG8_LDB(B1, 1, 1); PG8_SCHED; PG8_LDA(At, 1, 0); PG8_STAGE(PG8_SA(0, 1), a2 + hstep, voffA);
            PG8_WAIT_V(8); PG8_WAIT_L(0); PG8_BAR; PG8_MMA(0, 0, At, B0); PG8_MMA(0, 1, At, B1); PG8_BAR; PG8_SCHED;
            PG8_LDA(At, 1, 1); PG8_STAGE(PG8_SB(1, 0), b3, voffB); PG8_STAGE(PG8_SB(1, 1), b3 + hstep, voffB); PG8_STAGE(PG8_SA(1, 0), a3, voffA);
            PG8_WAIT_V(8); PG8_WAIT_L(0); PG8_BAR; PG8_MMA(1, 0, At, B0); PG8_MMA(1, 1, At, B1); PG8_BAR; PG8_SCHED;
            } else {
            PG8_LDB(B0, 0, 0); PG8_SCHED; PG8_LDA(At, 0, 0); PG8_STAGE(PG8_SA(1, 1), a1 + hstep, voffA);
            PG8_WAIT_L(8); PG8_BAR; PG8_WAIT_L(0); PG8_MMA(0, 0, At, B0); PG8_BAR; PG8_SCHED;
            PG8_LDB(B1, 0, 1); PG8_STAGE(PG8_SB(0, 0), b2, voffB);
            PG8_BAR; PG8_WAIT_L(0); PG8_MMA(0, 1, At, B1); PG8_BAR;
            PG8_LDA(At, 0, 1); PG8_STAGE(PG8_SA(0, 0), a2, voffA);
            PG8_BAR; PG8_WAIT_L(0); PG8_MMA(1, 0, At, B0); PG8_BAR; PG8_SCHED;
            PG8_STAGE(PG8_SB(0, 1), b2 + hstep, voffB);
            PG8_WAIT_V(6); PG8_BAR; PG8_MMA(1, 1, At, B1); PG8_BAR;
            PG8_LDB(B0, 1, 0); PG8_SCHED; PG8_LDA(At, 1, 0); PG8_STAGE(PG8_SA(0, 1), a2 + hstep, voffA);
            PG8_WAIT_L(8); PG8_BAR; PG8_WAIT_L(0); PG8_MMA(0, 0, At, B0); PG8_BAR; PG8_SCHED;
            PG8_LDB(B1, 1, 1); PG8_STAGE(PG8_SB(1, 0), b3, voffB);
            PG8_BAR; PG8_WAIT_L(0); PG8_MMA(0, 1, At, B1); PG8_BAR;
            PG8_LDA(At, 1, 1); PG8_STAGE(PG8_SA(1, 0), a3, voffA);
            PG8_BAR; PG8_WAIT_L(0); PG8_MMA(1, 0, At, B0); PG8_BAR; PG8_SCHED;
            PG8_STAGE(PG8_SB(1, 1), b3 + hstep, voffB);
            PG8_WAIT_V(6); PG8_BAR; PG8_MMA(1, 1, At, B1); PG8_BAR;
            }
        }
        if constexpr (ALIGN_EPI) { if (wr == 0) PG8_BAR; }
        if constexpr (!Epi::AFTER_DRAIN) { E(acc, cur, wr, wc, fr, fq); S.done(cur); }
        if (!has_next) break;
#pragma unroll
        for (int a = 0; a < 2; ++a)
#pragma unroll
            for (int b = 0; b < 2; ++b)
#pragma unroll
                for (int m = 0; m < 4; ++m)
#pragma unroll
                    for (int n = 0; n < 2; ++n) acc[a][b][m][n] = (f32x4){0.f, 0.f, 0.f, 0.f};
        cur = nxt; cA = nA; cB = nB; ++ui;
        if constexpr (ALIGN_EPI) { if (wr == 1) PG8_BAR; }
    }
    PG8_WAIT_V(0);
    if constexpr (!ALIGN_EPI) { if (wr == 0) PG8_BAR; }
    PG8_BAR;
    if constexpr (Epi::AFTER_DRAIN) { E.fused(acc, cur, wr, wc, fr, fq, lds, wid, lane); S.done(cur); }
#undef PG8_SA
#undef PG8_SB
#undef PG8_STAGE
#undef PG8_LDA
#undef PG8_LDB
#undef PG8_MMA
#undef PG8_WAIT_V
#undef PG8_WAIT_L
#undef PG8_BAR
#undef PG8_SCHED
}
}
#ifndef PG8_SP2
#define PG8_SP2 true
#endif
#ifndef PG8_ALIGN
#define PG8_ALIGN true
#endif
constexpr int NWAVES = 8;
#ifndef MK_PER_PHASE
#define MK_PER_PHASE 0
#endif

constexpr int BATCH = 8, SEQ = 4096, D = 1024, M = BATCH * SEQ, DIN = 1736, NP = 1792, FF = 4096, KO = 1536, NLAYER = 2;
constexpr int COL_Q = 512, COL_C = 1024, COL_IQ = 1152, COL_IK = 1664, COL_IW = 1728;
constexpr float ALPHA = 1.4142135623730951f, LN_EPS = 1e-5f;
constexpr int N_PHASES = 1 + 8 * NLAYER;

constexpr size_t MiB = 1u << 20;
constexpr size_t WS_CTL = 0, CTL_ZERO_BYTES = 1 * MiB;
constexpr size_t WS_SS = 47 * MiB;
constexpr size_t WS_WIN = 1 * MiB;
constexpr size_t WS_WO = 8 * MiB;
constexpr size_t WS_WUP = 14 * MiB;
constexpr size_t WS_WDN = 30 * MiB;
constexpr size_t WS_WUK = 46 * MiB;
constexpr size_t WS_XN = 48 * MiB;
constexpr size_t WS_PROJ = 112 * MiB;
constexpr size_t WS_MIX = 224 * MiB;
constexpr size_t WS_H = 112 * MiB;
constexpr size_t WS_END = 368 * MiB;
static_assert(WS_WIN + (size_t)NLAYER * NP * D * 2 <= WS_WO && WS_WO + (size_t)NLAYER * D * KO * 2 <= WS_WUP && WS_WUP + (size_t)NLAYER * FF * D * 2 <= WS_WDN &&
              WS_WDN + (size_t)NLAYER * D * FF * 2 <= WS_WUK && WS_WUK + (size_t)NLAYER * 128 * 512 * 2 <= WS_XN && WS_XN + (size_t)M * D * 2 <= WS_PROJ &&
              WS_PROJ + (size_t)M * NP * 2 <= WS_MIX && WS_MIX + (size_t)M * KO * 2 <= WS_H + (size_t)M * FF * 2 && WS_H + (size_t)M * FF * 2 <= WS_END, "d_ws map");
constexpr int CW_BAR = 4096;

constexpr int L_MAIN = 0;
constexpr int L_SEL = 131072;
constexpr int L_WH = L_SEL + 8192;
constexpr int L_SS = L_WH + 4096;
constexpr int L_LUT = L_SS + 2048;
constexpr int L_CNT = L_LUT + 4352;
constexpr int L_CCNT = L_CNT + 128;
constexpr int L_THR1 = L_CCNT + 128, L_NEED1 = L_THR1 + 128;
constexpr int L_RBUF = L_NEED1 + 128;
constexpr int L_G = L_RBUF + 1024;
constexpr int L_BM = L_G + 512;
constexpr int L_MISC = L_BM + 8192;
constexpr int LDS_BYTES = L_MISC + 128;
static_assert(LDS_BYTES <= 163840 && LDS_BYTES > 81920, "LDS map (more than half of the CU's LDS: exactly one workgroup per CU)");

#define GAS __attribute__((address_space(1)))
#define LAS __attribute__((address_space(3)))
typedef unsigned short bf16;
typedef unsigned v4u __attribute__((ext_vector_type(4)));
typedef float f32x4 __attribute__((ext_vector_type(4)));
typedef short bf16x8 __attribute__((ext_vector_type(8)));
typedef GAS unsigned gu32;
typedef GAS unsigned long long gu64;
#define RLX_AGENT __ATOMIC_RELAXED, __HIP_MEMORY_SCOPE_AGENT
#define LDS_WAIT() asm volatile("s_waitcnt lgkmcnt(0)" ::: "memory")
#define VM_WAIT() asm volatile("s_waitcnt vmcnt(0)" ::: "memory")
__device__ __forceinline__ unsigned long long rt() { return __builtin_amdgcn_s_memrealtime(); }
__device__ __forceinline__ unsigned f2bf(float f) { unsigned u = __builtin_bit_cast(unsigned, f); return (u + 0x7fffu + ((u >> 16) & 1u)) >> 16; }
__device__ __forceinline__ unsigned pk2(float lo, float hi) { return f2bf(lo) | (f2bf(hi) << 16); }
#define XB_TMO      128
#define XB_XCNT(j)  (256  + 64 * (j))
#define XB_XSUB(j)  (1280 + 64 * (j))
#define XB_XGEN(j)  (2304 + 64 * (j))
#define XB_TOP      3328
#define XB_TOPGEN   3392
#define XCD_BAR_WORDS 3456
#define XB_SPIN_CAP (1u << 18)

__device__ __forceinline__ unsigned xb_ld(unsigned* p)              { return __hip_atomic_load(p, __ATOMIC_RELAXED, __HIP_MEMORY_SCOPE_AGENT); }
__device__ __forceinline__ unsigned xb_add(unsigned* p, unsigned v) { return __hip_atomic_fetch_add(p, v, __ATOMIC_RELAXED, __HIP_MEMORY_SCOPE_AGENT); }
__device__ __forceinline__ unsigned xb_xcc_id() { return (unsigned)__builtin_amdgcn_s_getreg((3 << 11) | 20) & 0xFu; }
#define XB_SPIN(cond, bar) do { unsigned _sp = 0; while (cond) { __builtin_amdgcn_s_sleep(1); \
    if ((++_sp & 255u) == 0u) { if (xb_ld(&(bar)[XB_TMO])) break; if (_sp > XB_SPIN_CAP) { atomicAdd(&(bar)[XB_TMO], 1u); break; } } } } while (0)

struct XcdBarrier {
    unsigned* bar; unsigned x;
    volatile LAS unsigned* st;
};

__device__ __forceinline__ XcdBarrier xcd_barrier_post(unsigned* bar, volatile LAS unsigned* st) {
    XcdBarrier b; b.bar = bar; b.x = xb_xcc_id(); b.st = st;
    if (threadIdx.x == 0) (void)xb_add(&bar[XB_XCNT(b.x)], 1u);
    return b;
}
__device__ __forceinline__ void xcd_barrier_complete(unsigned* bar, unsigned x, unsigned& nloc, unsigned& nx) {
    const unsigned G = gridDim.x * gridDim.y * gridDim.z;
    unsigned sum, cnt, mine, sp = 0u;
    for (;;) {
        sum = 0u; cnt = 0u; mine = 0u;
#pragma unroll
        for (unsigned j = 0; j < 16; ++j) { const unsigned c = xb_ld(&bar[XB_XCNT(j)]); sum += c; cnt += (c > 0u) ? 1u : 0u; mine = (j == x) ? c : mine; }
        if (sum == G) break;
        __builtin_amdgcn_s_sleep(1);
        if ((++sp & 255u) == 0u) { if (xb_ld(&bar[XB_TMO])) break; if (sp > XB_SPIN_CAP) { atomicAdd(&bar[XB_TMO], 1u); break; } }
    }
    nloc = mine > 0u ? mine : 1u; nx = cnt > 0u ? cnt : 1u;
}

__device__ __forceinline__ void xcd_barrier(const XcdBarrier& b) {
    asm volatile("s_waitcnt vmcnt(0)" ::: "memory");
    __syncthreads();
    if (threadIdx.x == 0) {
        unsigned* bar = b.bar;
        __builtin_amdgcn_s_waitcnt(0);
        unsigned nloc = b.st[0], nx = b.st[1];
        if (nloc == 0u) { xcd_barrier_complete(bar, b.x, nloc, nx); b.st[0] = nloc; b.st[1] = nx; }
        const unsigned old = xb_add(&bar[XB_XSUB(b.x)], 1u);
        const unsigned gen = old / nloc;
        if (old + 1u == (gen + 1u) * nloc) {
            __builtin_amdgcn_fence(__ATOMIC_RELEASE, "agent");
            asm volatile("s_waitcnt vmcnt(0)" ::: "memory");
            const unsigned og = xb_add(&bar[XB_TOP], 1u);
            const unsigned tg = og / nx;
            if (og + 1u == (tg + 1u) * nx) xb_add(&bar[XB_TOPGEN], 1u);
            else XB_SPIN(xb_ld(&bar[XB_TOPGEN]) == tg, bar);
            __builtin_amdgcn_fence(__ATOMIC_ACQUIRE, "agent");
            xb_add(&bar[XB_XGEN(b.x)], 1u);
            asm volatile("s_waitcnt vmcnt(0)" ::: "memory");
        } else {
            XB_SPIN(xb_ld(&bar[XB_XGEN(b.x)]) == gen, bar);
            __builtin_amdgcn_fence(__ATOMIC_ACQUIRE, "agent");
            asm volatile("s_waitcnt vmcnt(0)" ::: "memory");
        }
    }
    __syncthreads();
}
struct Frame {
    LAS unsigned char* lds;
    int tid, lane, wave;
    int vcu, G;
    float* out;
    unsigned char* ws;
};
typedef float f32x2 __attribute__((ext_vector_type(2)));
__device__ __forceinline__ float wave_sum(float v) {
#pragma unroll
    for (int o = 1; o < 64; o <<= 1) v += __shfl_xor(v, o);
    return v;
}
__device__ __forceinline__ float bf2f(unsigned short v) { return __builtin_bit_cast(float, (unsigned)v << 16); }

__device__ __forceinline__ void tr_item(const float* W, int ldw, int nvalid, bf16* dst, int ldd, LAS float* scr, int lane) {
#pragma unroll 8
    for (int i = 0; i < 32; ++i) { const int kk = 2 * i + (lane >> 5), nn = lane & 31; scr[kk * 33 + nn] = nn < nvalid ? W[(size_t)kk * ldw + nn] : 0.f; }
    LDS_WAIT(); asm volatile("" ::: "memory");
    const int c = lane & 7;
#pragma unroll
    for (int j = 0; j < 4; ++j) { const int n = (lane >> 3) + 8 * j; const LAS float* s = scr + (8 * c) * 33 + n;
        v4u o; o.x = pk2(s[0 * 33], s[1 * 33]); o.y = pk2(s[2 * 33], s[3 * 33]); o.z = pk2(s[4 * 33], s[5 * 33]); o.w = pk2(s[6 * 33], s[7 * 33]);
        *(GAS v4u*)(dst + (size_t)n * ldd + 8 * c) = o; }
    LDS_WAIT(); asm volatile("" ::: "memory");
}
__device__ __forceinline__ void ln_row(const float* xrow, const float* g, const float* b, float* orow, bf16* xn, int lane) {
    const GAS f32x4* xr = (const GAS f32x4*)xrow + lane;
    f32x4 v[4]; float s = 0.f;
#pragma unroll
    for (int j = 0; j < 4; ++j) { v[j] = xr[64 * j]; s += (v[j].x + v[j].y) + (v[j].z + v[j].w); }
    const float mean = wave_sum(s) * (1.f / D); float s2 = 0.f;
#pragma unroll
    for (int j = 0; j < 4; ++j) { v[j] = v[j] - mean; s2 += (v[j].x * v[j].x + v[j].y * v[j].y) + (v[j].z * v[j].z + v[j].w * v[j].w); }
    const float rstd = 1.f / sqrtf(wave_sum(s2) * (1.f / D) + LN_EPS);
    GAS f32x4* o4 = (GAS f32x4*)orow + lane;
#pragma unroll
    for (int j = 0; j < 4; ++j) { const f32x4 gg = ((const GAS f32x4*)g)[lane + 64 * j], bb = ((const GAS f32x4*)b)[lane + 64 * j]; v[j] = v[j] * rstd * gg + bb; if (orow) o4[64 * j] = v[j]; }
    if (xn) { GAS unsigned long long* o8 = (GAS unsigned long long*)xn + lane;
#pragma unroll
        for (int j = 0; j < 4; ++j) o8[64 * j] = (unsigned long long)pk2(v[j].x, v[j].y) | ((unsigned long long)pk2(v[j].z, v[j].w) << 32); }
}
__device__ __forceinline__ void ln_row_b(const bf16* xrow, const float* g, const float* b, float* orow, bf16* xn, int lane) {
    float v[2][8]; float s = 0.f;
#pragma unroll
    for (int j = 0; j < 2; ++j) { const v4u w = *(const GAS v4u*)(xrow + 512 * j + 8 * lane);
        v[j][0] = __builtin_bit_cast(float, w.x << 16); v[j][1] = __builtin_bit_cast(float, w.x & 0xffff0000u); v[j][2] = __builtin_bit_cast(float, w.y << 16); v[j][3] = __builtin_bit_cast(float, w.y & 0xffff0000u);
        v[j][4] = __builtin_bit_cast(float, w.z << 16); v[j][5] = __builtin_bit_cast(float, w.z & 0xffff0000u); v[j][6] = __builtin_bit_cast(float, w.w << 16); v[j][7] = __builtin_bit_cast(float, w.w & 0xffff0000u);
#pragma unroll
        for (int e = 0; e < 8; ++e) s += v[j][e]; }
    const float mean = wave_sum(s) * (1.f / D); float s2 = 0.f;
#pragma unroll
    for (int j = 0; j < 2; ++j)
#pragma unroll
        for (int e = 0; e < 8; ++e) { v[j][e] -= mean; s2 += v[j][e] * v[j][e]; }
    const float rstd = 1.f / sqrtf(wave_sum(s2) * (1.f / D) + LN_EPS);
#pragma unroll
    for (int j = 0; j < 2; ++j) { const GAS f32x4* gp = (const GAS f32x4*)(g + 512 * j + 8 * lane); const GAS f32x4* bp = (const GAS f32x4*)(b + 512 * j + 8 * lane);
        const f32x4 g0 = gp[0], g1 = gp[1], b0 = bp[0], b1 = bp[1];
        f32x4 o0, o1;
#pragma unroll
        for (int e = 0; e < 4; ++e) { o0[e] = v[j][e] * rstd * g0[e] + b0[e]; o1[e] = v[j][4 + e] * rstd * g1[e] + b1[e]; }
        if (orow) { GAS f32x4* op = (GAS f32x4*)(orow + 512 * j + 8 * lane); op[0] = o0; op[1] = o1; }
        else { v4u w; w.x = pk2(o0[0], o0[1]); w.y = pk2(o0[2], o0[3]); w.z = pk2(o1[0], o1[1]); w.w = pk2(o1[2], o1[3]); *(GAS v4u*)(xn + 512 * j + 8 * lane) = w; } }
}
__device__ __forceinline__ void p0_prologue(Frame& F, const float* x_in, const float* emb_g, const float* emb_b, const float* w_in, const float* pool_w, const float* pool_scale,
                                            const float* w_uk, const float* w_uv, const float* w_o, const float* w_up, const float* w_down, const int pmask = 31) {
    LAS float* scr = (LAS float*)(F.lds + L_MAIN + F.wave * 16384);
    const int gw = F.vcu * NWAVES + F.wave, NGW = F.G * NWAVES, lane = F.lane;
    bf16* WIN = (bf16*)(F.ws + WS_WIN); bf16* WO = (bf16*)(F.ws + WS_WO); bf16* WUP = (bf16*)(F.ws + WS_WUP); bf16* WDN = (bf16*)(F.ws + WS_WDN); bf16* WUK = (bf16*)(F.ws + WS_WUK);
    constexpr int I_IN = (D / 64) * 40, I_O = (512 / 64) * (D / 32), I_UP = (D / 64) * (FF / 32), I_DN = (FF / 64) * (D / 32), I_L = I_IN + I_O + I_UP + I_DN;
    if (pmask & 1) for (int it = gw; it < NLAYER * I_L; it += NGW) {
        const int l = it / I_L; int r = it % I_L;
        if (r < I_IN) { const int kb = r / 40, nb = r % 40, n0 = 512 + 32 * nb;
            tr_item(w_in + (size_t)l * D * DIN + (size_t)(64 * kb) * DIN + n0, DIN, DIN - n0, WIN + (size_t)l * NP * D + (size_t)n0 * D + 64 * kb, D, scr, lane); continue; } r -= I_IN;
        if (r < I_O) { const int kb = r / 32, nb = r % 32;
            tr_item(w_o + (size_t)l * D * D + (size_t)(64 * kb) * D + 32 * nb, D, 32, WO + (size_t)l * D * KO + (size_t)(32 * nb) * KO + 64 * kb, KO, scr, lane); continue; } r -= I_O;
        if (r < I_UP) { const int kb = r / 128, nb = r % 128;
            tr_item(w_up + (size_t)l * D * FF + (size_t)(64 * kb) * FF + 32 * nb, FF, 32, WUP + (size_t)l * FF * D + (size_t)(32 * nb) * D + 64 * kb, D, scr, lane); continue; } r -= I_UP;
        { const int kb = r / 32, nb = r % 32;
            tr_item(w_down + (size_t)l * FF * D + (size_t)(64 * kb) * D + 32 * nb, D, 32, WDN + (size_t)l * D * FF + (size_t)(32 * nb) * FF + 64 * kb, FF, scr, lane); }
    }
    if (pmask & 2) for (int it = gw; it < NLAYER * 4 * 64; it += NGW) {
        const int l = it >> 8, g = (it >> 6) & 3, k0 = 16 * (it & 63), mm = lane & 15, g4 = lane >> 4;
        const float* wi = w_in + (size_t)l * D * DIN + (size_t)(k0 + mm) * DIN + g * 128 + 8 * g4; const float* pw = pool_w + ((size_t)(l * 4 + g) * 128) * 128 + mm;
        bf16x8 Af[4];
#pragma unroll
        for (int s = 0; s < 4; ++s) { const f32x4 u0 = *(const GAS f32x4*)(wi + 32 * s), u1 = *(const GAS f32x4*)(wi + 32 * s + 4);
            union { bf16x8 v; unsigned u[4]; } t; t.u[0] = pk2(u0[0], u0[1]); t.u[1] = pk2(u0[2], u0[3]); t.u[2] = pk2(u1[0], u1[1]); t.u[3] = pk2(u1[2], u1[3]); Af[s] = t.v; }
#pragma unroll 2
        for (int db = 0; db < 8; ++db) {
            f32x4 acc = (f32x4){0.f, 0.f, 0.f, 0.f};
#pragma unroll
            for (int s = 0; s < 4; ++s) { float bv[8];
#pragma unroll
                for (int j = 0; j < 8; ++j) bv[j] = pw[(size_t)(32 * s + 8 * g4 + j) * 128 + 16 * db];
                union { bf16x8 v; unsigned u[4]; } t; t.u[0] = pk2(bv[0], bv[1]); t.u[1] = pk2(bv[2], bv[3]); t.u[2] = pk2(bv[4], bv[5]); t.u[3] = pk2(bv[6], bv[7]);
                acc = __builtin_amdgcn_mfma_f32_16x16x32_bf16(Af[s], t.v, acc, 0, 0, 0); }
            const float sc = pool_scale[l * 512 + g * 128 + 16 * db + mm];
            const unsigned long long o = (unsigned long long)pk2(acc[0] * sc, acc[1] * sc) | ((unsigned long long)pk2(acc[2] * sc, acc[3] * sc) << 32);
            *(GAS unsigned long long*)(WIN + (size_t)l * NP * D + (size_t)(g * 128 + 16 * db + mm) * D + k0 + 4 * g4) = o;
        }
    }
    if (pmask & 4) for (int it = gw; it < NLAYER * 8 * 64; it += NGW) {
        const int l = it >> 9, h = (it >> 6) & 7, n0 = 16 * (it & 63), mm = lane & 15, g4 = lane >> 4;
        const float* wo = w_o + (size_t)l * D * D + (size_t)(512 + h * 64 + 8 * g4) * D + n0 + mm; const float* uv = w_uv + (size_t)l * 128 * 512 + (size_t)mm * 512 + h * 64 + 8 * g4;
        bf16x8 Bf[2];
#pragma unroll
        for (int s = 0; s < 2; ++s) { float bv[8];
#pragma unroll
            for (int j = 0; j < 8; ++j) bv[j] = wo[(size_t)(32 * s + j) * D];
            union { bf16x8 v; unsigned u[4]; } t; t.u[0] = pk2(bv[0], bv[1]); t.u[1] = pk2(bv[2], bv[3]); t.u[2] = pk2(bv[4], bv[5]); t.u[3] = pk2(bv[6], bv[7]); Bf[s] = t.v; }
#pragma unroll 2
        for (int cb = 0; cb < 8; ++cb) {
            f32x4 acc = (f32x4){0.f, 0.f, 0.f, 0.f};
#pragma unroll
            for (int s = 0; s < 2; ++s) { const f32x4 u0 = *(const GAS f32x4*)(uv + (size_t)(16 * cb) * 512 + 32 * s), u1 = *(const GAS f32x4*)(uv + (size_t)(16 * cb) * 512 + 32 * s + 4);
                union { bf16x8 v; unsigned u[4]; } t; t.u[0] = pk2(u0[0], u0[1]); t.u[1] = pk2(u0[2], u0[3]); t.u[2] = pk2(u1[0], u1[1]); t.u[3] = pk2(u1[2], u1[3]);
                acc = __builtin_amdgcn_mfma_f32_16x16x32_bf16(t.v, Bf[s], acc, 0, 0, 0); }
            const unsigned long long o = (unsigned long long)pk2(acc[0], acc[1]) | ((unsigned long long)pk2(acc[2], acc[3]) << 32);
            *(GAS unsigned long long*)(WO + (size_t)l * D * KO + (size_t)(n0 + mm) * KO + 512 + h * 128 + 16 * cb + 4 * g4) = o;
        }
    }
    if (pmask & 8) for (int i = gw * 64 + lane; i < NLAYER * 128 * 512; i += NGW * 64) WUK[i] = (bf16)f2bf(w_uk[i] * 0.125f);
    bf16* XN = (bf16*)(F.ws + WS_XN);
    if (pmask & 16) for (int m = gw; m < M; m += NGW) ln_row(x_in + (size_t)m * D, emb_g, emb_b, (float*)nullptr, XN + (size_t)m * D, lane);
}
__device__ __forceinline__ void ln_phase(Frame& F, const float* g, const float* b, bool last) {
    const int gw = F.vcu * NWAVES + F.wave, NGW = F.G * NWAVES; bf16* XN = (bf16*)(F.ws + WS_XN);
    for (int m = gw; m < M; m += NGW) ln_row_b(XN + (size_t)m * D, g, b, last ? F.out + (size_t)m * D : (float*)nullptr, XN + (size_t)m * D, F.lane);
}

namespace mixp {
typedef float f32x4 __attribute__((ext_vector_type(4)));
typedef short bf16x8 __attribute__((ext_vector_type(8)));
typedef unsigned short u16;
typedef unsigned short u16x4 __attribute__((ext_vector_type(4)));
typedef unsigned short u16x8 __attribute__((ext_vector_type(8)));
typedef unsigned u32x2 __attribute__((ext_vector_type(2)));
constexpr int CCAP = 1024;

__device__ __forceinline__ unsigned fkey(float f) { const unsigned b = __builtin_bit_cast(unsigned, f); const unsigned m = (unsigned)((int)b >> 31); return b ^ (m | 0x80000000u); }
__device__ __forceinline__ unsigned off_b(unsigned row, unsigned ch) { return 256u * row + 16u * (ch ^ (((row & 3u) << 2) | ((row >> 2) & 3u))); }
__device__ __forceinline__ unsigned cvtpk(float lo, float hi) { unsigned r; asm volatile("v_cvt_pk_bf16_f32 %0, %1, %2" : "=v"(r) : "v"(lo), "v"(hi)); return r; }

__device__ __forceinline__ void scan_hist(const LAS unsigned* hist, LAS unsigned* S, LAS unsigned* thr_out, LAS unsigned* need_out, int tid) {
    const int q = tid & 15, part = tid >> 4;
    unsigned sum = 0;
#pragma unroll 8
    for (int w = 0; w < 32; ++w) { const u32x2 v = *(const LAS u32x2*)(hist + (part * 32 + w) * 32 + 2 * q); sum += (v.x & 0xffffu) + (v.x >> 16) + (v.y & 0xffffu) + (v.y >> 16); }
    S[part * 16 + q] = sum;
    if (part == 0) { thr_out[q] = 0x7fffffffu; need_out[q] = 0u; }
    __syncthreads();
    const unsigned need = 256u;
    unsigned above = 0;
#pragma unroll 1
    for (int p2 = part + 1; p2 < 32; ++p2) above += S[p2 * 16 + q];
    if (above < need && above + sum >= need) {
#pragma unroll 1
        for (int w = 31; w >= 0; --w) { const u32x2 v = *(const LAS u32x2*)(hist + (part * 32 + w) * 32 + 2 * q); const unsigned hi = (v.x >> 16) + (v.y >> 16), lo = (v.x & 0xffffu) + (v.y & 0xffffu);
            if (above + hi >= need) { thr_out[q] = (unsigned)((part * 32 + w) * 2 + 1); need_out[q] = need - above; break; } above += hi;
            if (above + lo >= need) { thr_out[q] = (unsigned)((part * 32 + w) * 2); need_out[q] = need - above; break; } above += lo; }
    }
    __syncthreads();
}

template <int W, int NT>
__device__ __forceinline__ void pool_filter(const bf16* up, bf16* mp, int ts) {
    unsigned v[W - 1 + NT];
#pragma unroll
    for (int i = 0; i < W - 1 + NT; ++i) { const int t = ts - (W - 1) + i; v[i] = *(const unsigned*)(up + (size_t)(t < 0 ? 0 : t) * NP); if (t < 0) v[i] = 0u; }
    float s0 = 0.f, s1 = 0.f;
#pragma unroll
    for (int i = 0; i < W - 1; ++i) { s0 += bf2f((u16)(v[i] & 0xffff)); s1 += bf2f((u16)(v[i] >> 16)); }
#pragma unroll
    for (int i = 0; i < NT; ++i) { const int t = ts + i; const unsigned cv = v[W - 1 + i]; const float c0 = bf2f((u16)(cv & 0xffff)), c1 = bf2f((u16)(cv >> 16));
        s0 += c0; s1 += c1;
        const float inv = 1.0f / (float)(t + 1 < W ? t + 1 : W);
        *(unsigned*)(mp + (size_t)t * KO) = cvtpk(s0 * inv - c0, s1 * inv - c1);
        s0 -= bf2f((u16)(v[i] & 0xffff)); s1 -= bf2f((u16)(v[i] >> 16)); }
}

__device__ __forceinline__ void mix_unit(Frame& F, int layer, int b, int j) {
    int tid_ = F.tid; asm volatile("" : "+v"(tid_));
    const int tid = tid_, lane = tid & 63, wave = F.wave;
    const bf16* PROJ = (const bf16*)(F.ws + WS_PROJ); bf16* MIX = (bf16*)(F.ws + WS_MIX);
    const bf16* WUK = (const bf16*)(F.ws + WS_WUK) + (size_t)layer * 128 * 512;
    LAS unsigned char* lds = F.lds;
    LAS unsigned* hist = (LAS unsigned*)(lds + L_MAIN);
    LAS unsigned* candu = (LAS unsigned*)(lds + L_MAIN);
    LAS u16* candi = (LAS u16*)(lds + L_MAIN + 65536);
    LAS u16* sel = (LAS u16*)(lds + L_SEL);
    LAS unsigned* bm = (LAS unsigned*)(lds + L_BM);
    LAS unsigned* Ssum = (LAS unsigned*)(lds + L_SS);
    LAS unsigned* cnt = (LAS unsigned*)(lds + L_CNT); LAS unsigned* ccnt = (LAS unsigned*)(lds + L_CCNT);
    LAS unsigned* thr1 = (LAS unsigned*)(lds + L_THR1); LAS unsigned* need1 = (LAS unsigned*)(lds + L_NEED1);
    const int brow = b * SEQ, t0 = 16 * j, tok0 = brow + t0;

    __syncthreads();
    for (int rep_ = 0; rep_ < ((DBG_REPM & 1) ? 2 : 1); ++rep_) {
        const int cp = tid & 255, th = tid >> 8, ch = 2 * cp, ts = t0 + 8 * th;
        const bf16* up = PROJ + (size_t)brow * NP + ch; bf16* mp = MIX + (size_t)brow * KO + ch;
        switch (wave & 3) { case 0: pool_filter<2, 8>(up, mp, ts); break; case 1: pool_filter<4, 8>(up, mp, ts); break; case 2: pool_filter<8, 8>(up, mp, ts); break; default: pool_filter<16, 8>(up, mp, ts); break; }
    }
    for (int rep_ = 0; rep_ < ((DBG_REPM & 2) ? 2 : 1); ++rep_) {
    if (rep_) __syncthreads();
    if (tid < 16) { cnt[tid] = 0u; ccnt[tid] = 0u; }
    if (j < 16) {
        for (int i = tid; i < 16 * 256; i += 512) sel[i] = (u16)(i & 255);
        __syncthreads();
        if (tid < 16) cnt[tid] = (unsigned)(t0 + tid + 1);
        __syncthreads();
    } else {
        const int n = lane & 15, g = lane >> 4, q = n, tq = t0 + q, hq = 2 * n + (g & 1);
        const bf16* qrow = PROJ + (size_t)(tok0 + q) * NP;
        bf16x8 Bq[8][2]; float wq[8];
#pragma unroll
        for (int h = 0; h < 8; ++h) { wq[h] = bf2f(qrow[COL_IW + h]);
#pragma unroll
            for (int s = 0; s < 2; ++s) Bq[h][s] = *(const bf16x8*)(qrow + COL_IQ + 64 * h + 32 * s + 8 * g); }
        bf16x8 Qh[2], Ql[2];
#pragma unroll
        for (int s = 0; s < 2; ++s) { float a[8];
#pragma unroll
            for (int e = 0; e < 8; ++e) { a[e] = 0.f;
#pragma unroll
                for (int h = 0; h < 8; ++h) a[e] += wq[h] * bf2f((u16)Bq[h][s][e]); }
            union { bf16x8 v; unsigned u[4]; } hi, lo;
#pragma unroll
            for (int e = 0; e < 4; ++e) { hi.u[e] = cvtpk(a[2 * e], a[2 * e + 1]);
                lo.u[e] = cvtpk(a[2 * e] - bf2f((u16)(hi.u[e] & 0xffff)), a[2 * e + 1] - bf2f((u16)(hi.u[e] >> 16))); }
            Qh[s] = hi.v; Ql[s] = lo.v; }
        const int ktmax = (t0 + 15) >> 5;
        { f32x4 z = (f32x4){0.f, 0.f, 0.f, 0.f}; for (int i = tid; i < 8192; i += 512) *(LAS f32x4*)(hist + 4 * i) = z; }
        __syncthreads();
        const bf16* kbase = PROJ + (size_t)(brow + n) * NP + COL_IK + 8 * g;
#pragma unroll 1
        for (int pass = 0; pass < 2; ++pass) {
            const unsigned b1 = pass ? thr1[q] : 0u;
            bf16x8 An[2][2];
            { const bf16* krow = kbase + (size_t)(32 * (wave <= ktmax ? wave : 0)) * NP;
#pragma unroll
                for (int kb = 0; kb < 2; ++kb)
#pragma unroll
                    for (int s = 0; s < 2; ++s) An[kb][s] = *(const bf16x8*)(krow + (size_t)(16 * kb) * NP + 32 * s); }
#pragma unroll 1
            for (int kt = wave; kt <= ktmax; kt += 8) {
                bf16x8 A[2][2];
#pragma unroll
                for (int kb = 0; kb < 2; ++kb)
#pragma unroll
                    for (int s = 0; s < 2; ++s) A[kb][s] = An[kb][s];
                { const bf16* krow = kbase + (size_t)(32 * (kt + 8 <= ktmax ? kt + 8 : kt)) * NP;
#pragma unroll
                    for (int kb = 0; kb < 2; ++kb)
#pragma unroll
                        for (int s = 0; s < 2; ++s) An[kb][s] = *(const bf16x8*)(krow + (size_t)(16 * kb) * NP + 32 * s); }
                f32x4 L[2];
#pragma unroll
                for (int kb = 0; kb < 2; ++kb) { L[kb] = (f32x4){0.f, 0.f, 0.f, 0.f};
#pragma unroll
                    for (int s = 0; s < 2; ++s) { L[kb] = __builtin_amdgcn_mfma_f32_16x16x32_bf16(A[kb][s], Qh[s], L[kb], 0, 0, 0); L[kb] = __builtin_amdgcn_mfma_f32_16x16x32_bf16(A[kb][s], Ql[s], L[kb], 0, 0, 0); } }
                float sc[8];
#pragma unroll
                for (int r = 0; r < 8; ++r) sc[r] = L[r >> 2][r & 3];
                f32x4 C0, C1;
#define MIX_HEAD_MFMA(h) do { C0 = (f32x4){0.f, 0.f, 0.f, 0.f}; C1 = (f32x4){0.f, 0.f, 0.f, 0.f}; \
                    C0 = __builtin_amdgcn_mfma_f32_16x16x32_bf16(A[0][0], Bq[h][0], C0, 0, 0, 0); C1 = __builtin_amdgcn_mfma_f32_16x16x32_bf16(A[1][0], Bq[h][0], C1, 0, 0, 0); \
                    C0 = __builtin_amdgcn_mfma_f32_16x16x32_bf16(A[0][1], Bq[h][1], C0, 0, 0, 0); C1 = __builtin_amdgcn_mfma_f32_16x16x32_bf16(A[1][1], Bq[h][1], C1, 0, 0, 0); } while (0)
#define MIX_HEAD_FMA(h) asm volatile("s_nop 6\n\tv_fma_f32 %0, %8, |%9|, %0\n\tv_fma_f32 %1, %8, |%10|, %1\n\tv_fma_f32 %2, %8, |%11|, %2\n\tv_fma_f32 %3, %8, |%12|, %3\n\t" \
                                     "v_fma_f32 %4, %8, |%13|, %4\n\tv_fma_f32 %5, %8, |%14|, %5\n\tv_fma_f32 %6, %8, |%15|, %6\n\tv_fma_f32 %7, %8, |%16|, %7" \
                                     : "+v"(sc[0]), "+v"(sc[1]), "+v"(sc[2]), "+v"(sc[3]), "+v"(sc[4]), "+v"(sc[5]), "+v"(sc[6]), "+v"(sc[7]) \
                                     : "v"(wq[h]), "v"(C0[0]), "v"(C0[1]), "v"(C0[2]), "v"(C0[3]), "v"(C1[0]), "v"(C1[1]), "v"(C1[2]), "v"(C1[3]))
#pragma unroll
                for (int h = 0; h < 8; ++h) { MIX_HEAD_MFMA(h); MIX_HEAD_FMA(h); }
#undef MIX_HEAD_MFMA
#undef MIX_HEAD_FMA
                const int key0 = 32 * kt + 4 * g;
                if (kt == ktmax) {
#pragma unroll
                    for (int r = 0; r < 8; ++r) if (key0 + 16 * (r >> 2) + (r & 3) > tq) sc[r] = -__builtin_inff();
                }
                unsigned u[8];
#pragma unroll
                for (int r = 0; r < 8; ++r) u[r] = fkey(sc[r]);
                if (pass == 0) {
#pragma unroll
                    for (int r = 0; r < 8; ++r) { const unsigned bin = u[r] >> 21; __hip_atomic_fetch_add(hist + (bin >> 1) * 32 + hq, 1u << ((bin & 1u) * 16u), __ATOMIC_RELAXED, __HIP_MEMORY_SCOPE_WORKGROUP); }
                } else {
                    unsigned selbits = 0u, cmask = 0u;
#pragma unroll
                    for (int r = 0; r < 8; ++r) { const unsigned bin = u[r] >> 21; if (bin > b1) selbits |= 1u << (4 * g + (r & 3) + 16 * (r >> 2)); else if (bin == b1) cmask |= 1u << r; }
                    selbits |= (unsigned)__shfl_xor((int)selbits, 16); selbits |= (unsigned)__shfl_xor((int)selbits, 32);
                    if (g == 0) bm[q * 128 + kt] = selbits;
                    if (cmask) {
                        unsigned slot = __hip_atomic_fetch_add(ccnt + q, (unsigned)__builtin_popcount(cmask), __ATOMIC_RELAXED, __HIP_MEMORY_SCOPE_WORKGROUP);
#pragma unroll
                        for (int r = 0; r < 8; ++r) if (cmask & (1u << r)) { if (slot < (unsigned)CCAP) { candu[q * CCAP + slot] = u[r]; candi[q * CCAP + slot] = (u16)(key0 + 16 * (r >> 2) + (r & 3)); } ++slot; }
                    }
                }
            }
            __syncthreads();
            if (pass == 0) scan_hist(hist, Ssum, thr1, need1, tid);
        }
        {
            LAS unsigned* wh = (LAS unsigned*)(lds + L_WH) + wave * 128;
#pragma unroll 1
            for (int qi = 0; qi < 2; ++qi) {
                const int q2 = 2 * wave + qi;
                int nc = __builtin_amdgcn_readfirstlane((int)ccnt[q2]); nc = nc < CCAP ? nc : CCAP;
                unsigned need = (unsigned)__builtin_amdgcn_readfirstlane((int)need1[q2]);
                unsigned base = (unsigned)__builtin_amdgcn_readfirstlane((int)cnt[q2]);
                unsigned cu[16];
#pragma unroll
                for (int k = 0; k < 16; ++k) { const int i = lane + 64 * k; cu[k] = i < nc ? (candu[q2 * CCAP + i] & 0x1fffffu) : 0x80000000u; }
                unsigned prefix = 0u;
#pragma unroll
                for (int lv = 0; lv < 3; ++lv) {
                    const int shift = 14 - 7 * lv;
                    *(LAS u32x2*)(wh + 2 * lane) = (u32x2){0u, 0u};
                    asm volatile("s_waitcnt lgkmcnt(0)" ::: "memory");
#pragma unroll
                    for (int k = 0; k < 16; ++k) if ((cu[k] >> (shift + 7)) == prefix) __hip_atomic_fetch_add(wh + ((cu[k] >> shift) & 127u), 1u, __ATOMIC_RELAXED, __HIP_MEMORY_SCOPE_WORKGROUP);
                    asm volatile("s_waitcnt lgkmcnt(0)" ::: "memory");
                    const u32x2 c01 = *(const LAS u32x2*)(wh + 2 * lane);
                    const unsigned tot = c01.x + c01.y; unsigned T = tot;
#pragma unroll
                    for (int d = 1; d < 64; d <<= 1) { const unsigned t = (unsigned)__shfl_down((int)T, d); T += (lane + d < 64) ? t : 0u; }
                    const unsigned long long mk = __ballot(T >= need);
                    const int ls = mk ? 63 - __builtin_clzll(mk) : 0;
                    const unsigned Ts = (unsigned)__builtin_amdgcn_readlane((int)T, ls), tots = (unsigned)__builtin_amdgcn_readlane((int)tot, ls), c1s = (unsigned)__builtin_amdgcn_readlane((int)c01.y, ls);
                    const unsigned excl = Ts - tots; unsigned bin;
                    if (excl + c1s >= need) { bin = 2u * ls + 1u; need -= excl; } else { bin = 2u * ls; need -= excl + c1s; }
                    prefix = (prefix << 7) | bin;
                }
                unsigned eqbits = 0u;
#pragma unroll
                for (int k = 0; k < 16; ++k) {
                    if (cu[k] == prefix) eqbits |= 1u << k;
                    if (cu[k] < 0x80000000u && cu[k] > prefix) { const unsigned id = candi[q2 * CCAP + lane + 64 * k]; __hip_atomic_fetch_or(bm + q2 * 128 + (id >> 5), 1u << (id & 31u), __ATOMIC_RELAXED, __HIP_MEMORY_SCOPE_WORKGROUP); }
                }
#pragma unroll 1
                for (unsigned it = 0; it < need; ++it) {
                    unsigned mymin = 0xffffu;
#pragma unroll
                    for (int k = 0; k < 16; ++k) if (eqbits & (1u << k)) { const unsigned id = candi[q2 * CCAP + lane + 64 * k]; mymin = id < mymin ? id : mymin; }
                    unsigned wmin = mymin;
#pragma unroll
                    for (int o = 1; o < 64; o <<= 1) { const unsigned t = (unsigned)__shfl_xor((int)wmin, o); wmin = t < wmin ? t : wmin; }
                    if (wmin == 0xffffu) break;
                    if (lane == 0) __hip_atomic_fetch_or(bm + q2 * 128 + (wmin >> 5), 1u << (wmin & 31u), __ATOMIC_RELAXED, __HIP_MEMORY_SCOPE_WORKGROUP);
#pragma unroll
                    for (int k = 0; k < 16; ++k) if ((eqbits & (1u << k)) && candi[q2 * CCAP + lane + 64 * k] == wmin) eqbits &= ~(1u << k);
                }
                asm volatile("s_waitcnt lgkmcnt(0)" ::: "memory");
                {
                    const int nw = ktmax + 1;
                    unsigned w0 = 2 * lane < nw ? bm[q2 * 128 + 2 * lane] : 0u, w1 = 2 * lane + 1 < nw ? bm[q2 * 128 + 2 * lane + 1] : 0u;
                    const unsigned c = (unsigned)(__builtin_popcount(w0) + __builtin_popcount(w1));
                    unsigned inc = c;
#pragma unroll
                    for (int d = 1; d < 64; d <<= 1) { const unsigned t = (unsigned)__shfl_up((int)inc, d); inc += (lane >= d) ? t : 0u; }
                    unsigned pos = inc - c;
                    while (w0) { const int bpos = __builtin_ctz(w0); w0 &= w0 - 1u; if (pos < 256u) sel[q2 * 256 + pos] = (u16)(64 * lane + bpos); ++pos; }
                    while (w1) { const int bpos = __builtin_ctz(w1); w1 &= w1 - 1u; if (pos < 256u) sel[q2 * 256 + pos] = (u16)(64 * lane + 32 + bpos); ++pos; }
                    const unsigned total = (unsigned)__builtin_amdgcn_readlane((int)inc, 63);
                    if (lane == 0) cnt[q2] = total < 256u ? total : 256u;
                }
            }
        }
        __syncthreads();
    }
    }
    LAS unsigned char* QL = lds + L_MAIN + 65536;
    const LAS float* gtab = (const LAS float*)(lds + L_G);
    {
        const int h = wave, n = lane & 15, g = lane >> 4;
        const bf16* qp = PROJ + (size_t)(tok0 + n) * NP + COL_Q + 64 * h + 8 * g;
        const bf16x8 q0 = *(const bf16x8*)qp, q1 = *(const bf16x8*)(qp + 32);
#pragma unroll
        for (int cb = 0; cb < 8; ++cb) {
            const bf16* wp = WUK + (size_t)(16 * cb + n) * 512 + 64 * h + 8 * g;
            f32x4 acc = (f32x4){0.f, 0.f, 0.f, 0.f};
            acc = __builtin_amdgcn_mfma_f32_16x16x32_bf16(*(const bf16x8*)wp, q0, acc, 0, 0, 0);
            acc = __builtin_amdgcn_mfma_f32_16x16x32_bf16(*(const bf16x8*)(wp + 32), q1, acc, 0, 0, 0);
            const f32x4 gg = *(const LAS f32x4*)(gtab + 16 * cb + 4 * g);
            u32x2 o; o.x = cvtpk(acc[0] * gg[0] * 1.44269504f, acc[1] * gg[1] * 1.44269504f); o.y = cvtpk(acc[2] * gg[2] * 1.44269504f, acc[3] * gg[3] * 1.44269504f);
            *(LAS u32x2*)(QL + n * 2048 + h * 256 + (16 * cb + 4 * g) * 2) = o;
        }
    }
    __syncthreads();
    for (int rep_ = 0; rep_ < ((DBG_REPM & 4) ? 2 : 1); ++rep_) {
        const int n = lane & 15, g = lane >> 4, hh = n & 7, m = n;
        const LAS float* lut = (const LAS float*)(lds + L_LUT);
        LAS unsigned char* T = lds + L_MAIN + wave * 8192;
        const unsigned tbase = (unsigned)(size_t)T;
        const int kap0 = 8 * (m >> 2) + 4 * ((m >> 1) & 1) + (m & 3), kap1 = kap0 ^ 4;
        unsigned tra[8][2];
#pragma unroll
        for (int cb = 0; cb < 8; ++cb)
#pragma unroll
            for (int t = 0; t < 2; ++t) tra[cb][t] = tbase + off_b((unsigned)(8 * g + 4 * t + ((lane & 15) >> 2)), (unsigned)(2 * cb + ((lane & 3) >> 1))) + 8u * (lane & 1);
        unsigned wra[2][4];
#pragma unroll
        for (int s = 0; s < 4; ++s) { wra[0][s] = off_b((unsigned)kap0, (unsigned)(4 * s + g)); wra[1][s] = off_b((unsigned)kap1, (unsigned)(4 * s + g)); }
        const float b31 = lut[128 * 8 + hh];
        const bool dmy = ((DBG_REPM & 4) != 0) && rep_ == 0;
#pragma unroll 1
        for (int qi = 0; qi < 2; ++qi) {
            const int q = wave * 2 + qi, tq = t0 + q, nv = __builtin_amdgcn_readfirstlane((int)cnt[q]), nch = (nv + 31) >> 5;
            const LAS u16* selq = sel + q * 256;
            bf16x8 Bq[4];
#pragma unroll
            for (int s = 0; s < 4; ++s) { Bq[s] = *(const LAS bf16x8*)(QL + q * 2048 + hh * 256 + (32 * s + 8 * g) * 2); if (n >= 8) Bq[s] = (bf16x8){0, 0, 0, 0, 0, 0, 0, 0}; }
            float mref = 0.f, lrun = 0.f; f32x4 O[8];
#pragma unroll
            for (int cb = 0; cb < 8; ++cb) O[cb] = (f32x4){0.f, 0.f, 0.f, 0.f};
            bf16x8 xa0[4], xa1[4], xb0[4], xb1[4];
#define MIX_GATHER(CH, D0, D1) do { if (dmy && (DBG_SKIP & 1024)) break; const int p0_ = 32 * (CH) + kap0, p1_ = 32 * (CH) + kap1; \
                int i0_ = p0_ < nv ? (int)selq[p0_] : 0, i1_ = p1_ < nv ? (int)selq[p1_] : 0; if ((DBG_SKIP & 64) && rep_ == 0) { i0_ = lane & 15; i1_ = 16 + (lane & 15); } \
                const bf16* r0_ = PROJ + (size_t)(brow + i0_) * NP + COL_C + 8 * g; const bf16* r1_ = PROJ + (size_t)(brow + i1_) * NP + COL_C + 8 * g; \
                _Pragma("unroll") for (int s = 0; s < 4; ++s) { D0[s] = *(const bf16x8*)(r0_ + 32 * s); D1[s] = *(const bf16x8*)(r1_ + 32 * s); } } while (0)
#define MIX_CHUNK(CH, A0, A1, NEXT_GATHER) do { \
                const int last_ = 32 * (CH) + 31 < nv ? 32 * (CH) + 31 : nv - 1; \
                const bool far_ = __builtin_amdgcn_readfirstlane(tq - (int)selq[last_]) >= 128; \
                f32x4 S0 = (f32x4){0.f, 0.f, 0.f, 0.f}, S1 = S0, S2 = S0, S3 = S0; \
                S0 = __builtin_amdgcn_mfma_f32_16x16x32_bf16(A0[0], Bq[0], S0, 0, 0, 0); S1 = __builtin_amdgcn_mfma_f32_16x16x32_bf16(A1[0], Bq[0], S1, 0, 0, 0); \
                S2 = __builtin_amdgcn_mfma_f32_16x16x32_bf16(A0[1], Bq[1], S2, 0, 0, 0); S3 = __builtin_amdgcn_mfma_f32_16x16x32_bf16(A1[1], Bq[1], S3, 0, 0, 0); \
                S0 = __builtin_amdgcn_mfma_f32_16x16x32_bf16(A0[2], Bq[2], S0, 0, 0, 0); S1 = __builtin_amdgcn_mfma_f32_16x16x32_bf16(A1[2], Bq[2], S1, 0, 0, 0); \
                S2 = __builtin_amdgcn_mfma_f32_16x16x32_bf16(A0[3], Bq[3], S2, 0, 0, 0); S3 = __builtin_amdgcn_mfma_f32_16x16x32_bf16(A1[3], Bq[3], S3, 0, 0, 0); \
                if (!(dmy && (DBG_SKIP & 128))) { _Pragma("unroll") for (int s = 0; s < 4; ++s) { *(LAS bf16x8*)(T + wra[0][s]) = A0[s]; *(LAS bf16x8*)(T + wra[1][s]) = A1[s]; } } \
                NEXT_GATHER; \
                float lg[8]; \
                lg[0] = S0[0] + S2[0]; lg[1] = S0[1] + S2[1]; lg[6] = S0[2] + S2[2]; lg[7] = S0[3] + S2[3]; lg[4] = S1[0] + S3[0]; lg[5] = S1[1] + S3[1]; lg[2] = S1[2] + S3[2]; lg[3] = S1[3] + S3[3]; \
                if (far_) { _Pragma("unroll") for (int jx = 0; jx < 8; ++jx) lg[jx] += b31; } \
                else { const u16x8 id8 = *(const LAS u16x8*)(selq + 32 * (CH) + 8 * g); \
                    _Pragma("unroll") for (int jx = 0; jx < 8; ++jx) { int dist = tq - (int)id8[jx]; dist = dist < 0 ? 0 : (dist > 128 ? 128 : dist); lg[jx] += lut[dist * 8 + hh]; } } \
                if (32 * (CH) + 32 > nv) { _Pragma("unroll") for (int jx = 0; jx < 8; ++jx) if (32 * (CH) + 8 * g + jx >= nv) lg[jx] = -1e30f; } \
                if ((CH) == 0) { float cm = fmaxf(fmaxf(fmaxf(lg[0], lg[1]), fmaxf(lg[2], lg[3])), fmaxf(fmaxf(lg[4], lg[5]), fmaxf(lg[6], lg[7]))); \
                    cm = fmaxf(cm, __shfl_xor(cm, 16)); cm = fmaxf(cm, __shfl_xor(cm, 32)); mref = cm; } \
                float pp[8]; \
                if (dmy && (DBG_SKIP & 512)) { _Pragma("unroll") for (int jx = 0; jx < 8; ++jx) pp[jx] = lg[jx]; } else { \
                _Pragma("unroll") for (int jx = 0; jx < 8; ++jx) { pp[jx] = __builtin_amdgcn_exp2f(__builtin_amdgcn_fmed3f(lg[jx] - mref, -200.f, 100.f)); lrun += pp[jx]; } } \
                union { bf16x8 v; unsigned u[4]; } P; \
                P.u[0] = cvtpk(pp[0], pp[1]); P.u[1] = cvtpk(pp[2], pp[3]); P.u[2] = cvtpk(pp[4], pp[5]); P.u[3] = cvtpk(pp[6], pp[7]); \
                if (dmy && (DBG_SKIP & 256)) { O[0][0] += __builtin_bit_cast(float, P.u[0] ^ P.u[1] ^ P.u[2] ^ P.u[3]); break; } \
                u16x4 x0, x1, x2, x3, x4, x5, x6, x7, y0, y1, y2, y3, y4, y5, y6, y7; \
                asm volatile("s_waitcnt lgkmcnt(0)\n\tds_read_b64_tr_b16 %0, %8\n\tds_read_b64_tr_b16 %1, %9\n\tds_read_b64_tr_b16 %2, %10\n\tds_read_b64_tr_b16 %3, %11\n\t" \
                             "ds_read_b64_tr_b16 %4, %12\n\tds_read_b64_tr_b16 %5, %13\n\tds_read_b64_tr_b16 %6, %14\n\tds_read_b64_tr_b16 %7, %15" \
                             : "=&v"(x0), "=&v"(x1), "=&v"(x2), "=&v"(x3), "=&v"(x4), "=&v"(x5), "=&v"(x6), "=&v"(x7) \
                             : "v"(tra[0][0]), "v"(tra[0][1]), "v"(tra[1][0]), "v"(tra[1][1]), "v"(tra[2][0]), "v"(tra[2][1]), "v"(tra[3][0]), "v"(tra[3][1]) : "memory"); \
                asm volatile("ds_read_b64_tr_b16 %0, %8\n\tds_read_b64_tr_b16 %1, %9\n\tds_read_b64_tr_b16 %2, %10\n\tds_read_b64_tr_b16 %3, %11\n\t" \
                             "ds_read_b64_tr_b16 %4, %12\n\tds_read_b64_tr_b16 %5, %13\n\tds_read_b64_tr_b16 %6, %14\n\tds_read_b64_tr_b16 %7, %15\n\ts_waitcnt lgkmcnt(0)" \
                             : "=&v"(y0), "=&v"(y1), "=&v"(y2), "=&v"(y3), "=&v"(y4), "=&v"(y5), "=&v"(y6), "=&v"(y7) \
                             : "v"(tra[4][0]), "v"(tra[4][1]), "v"(tra[5][0]), "v"(tra[5][1]), "v"(tra[6][0]), "v"(tra[6][1]), "v"(tra[7][0]), "v"(tra[7][1]) : "memory"); \
                __builtin_amdgcn_sched_barrier(0);      \
                union { bf16x8 v; u16x4 h[2]; } A_; \
                A_.h[0] = x0; A_.h[1] = x1; O[0] = __builtin_amdgcn_mfma_f32_16x16x32_bf16(A_.v, P.v, O[0], 0, 0, 0); \
                A_.h[0] = x2; A_.h[1] = x3; O[1] = __builtin_amdgcn_mfma_f32_16x16x32_bf16(A_.v, P.v, O[1], 0, 0, 0); \
                A_.h[0] = x4; A_.h[1] = x5; O[2] = __builtin_amdgcn_mfma_f32_16x16x32_bf16(A_.v, P.v, O[2], 0, 0, 0); \
                A_.h[0] = x6; A_.h[1] = x7; O[3] = __builtin_amdgcn_mfma_f32_16x16x32_bf16(A_.v, P.v, O[3], 0, 0, 0); \
                A_.h[0] = y0; A_.h[1] = y1; O[4] = __builtin_amdgcn_mfma_f32_16x16x32_bf16(A_.v, P.v, O[4], 0, 0, 0); \
                A_.h[0] = y2; A_.h[1] = y3; O[5] = __builtin_amdgcn_mfma_f32_16x16x32_bf16(A_.v, P.v, O[5], 0, 0, 0); \
                A_.h[0] = y4; A_.h[1] = y5; O[6] = __builtin_amdgcn_mfma_f32_16x16x32_bf16(A_.v, P.v, O[6], 0, 0, 0); \
                A_.h[0] = y6; A_.h[1] = y7; O[7] = __builtin_amdgcn_mfma_f32_16x16x32_bf16(A_.v, P.v, O[7], 0, 0, 0); } while (0)
            MIX_GATHER(0, xa0, xa1);
            if (nch > 1) MIX_GATHER(1, xb0, xb1);
#pragma unroll 1
            for (int ch = 0; ch < nch; ch += 2) {
                MIX_CHUNK(ch, xa0, xa1, if (ch + 2 < nch) MIX_GATHER(ch + 2, xa0, xa1));
                if (ch + 1 < nch) MIX_CHUNK(ch + 1, xb0, xb1, if (ch + 3 < nch) MIX_GATHER(ch + 3, xb0, xb1));
            }
#undef MIX_CHUNK
            float lt = lrun; lt += __shfl_xor(lt, 16); lt += __shfl_xor(lt, 32);
            const float inv = 1.0f / lt;
            if (n < 8) {
                bf16* op = MIX + (size_t)(tok0 + q) * KO + 512 + n * 128 + 4 * g;
#pragma unroll
                for (int cb = 0; cb < 8; ++cb) { const f32x4 gg = *(const LAS f32x4*)(gtab + 16 * cb + 4 * g);
                    u32x2 o; o.x = cvtpk(O[cb][0] * inv * gg[0], O[cb][1] * inv * gg[1]); o.y = cvtpk(O[cb][2] * inv * gg[2], O[cb][3] * inv * gg[3]);
                    *(u32x2*)(op + 16 * cb) = o; }
            }
        }
    }
}

#undef MIX_GATHER
__device__ __forceinline__ void cnorm_phase(Frame& F) {
    bf16* PROJ = (bf16*)(F.ws + WS_PROJ);
    const int gw = F.vcu * NWAVES + F.wave, NGW = F.G * NWAVES, lane = F.lane;
    for (int r4 = gw; r4 < M / 4; r4 += NGW) {
        bf16* p = PROJ + (size_t)(4 * r4 + (lane >> 4)) * NP + COL_C + 8 * (lane & 15);
        const v4u w = *(const GAS v4u*)p;
        float v[8] = {__builtin_bit_cast(float, w.x << 16), __builtin_bit_cast(float, w.x & 0xffff0000u), __builtin_bit_cast(float, w.y << 16), __builtin_bit_cast(float, w.y & 0xffff0000u),
                      __builtin_bit_cast(float, w.z << 16), __builtin_bit_cast(float, w.z & 0xffff0000u), __builtin_bit_cast(float, w.w << 16), __builtin_bit_cast(float, w.w & 0xffff0000u)};
        float ss = 0.f;
#pragma unroll
        for (int e = 0; e < 8; ++e) ss += v[e] * v[e];
        ss += __shfl_xor(ss, 1); ss += __shfl_xor(ss, 2); ss += __shfl_xor(ss, 4); ss += __shfl_xor(ss, 8);
        const float r = 1.0f / sqrtf(ss * (1.0f / 128.0f) + LN_EPS);
        v4u o; o.x = cvtpk(v[0] * r, v[1] * r); o.y = cvtpk(v[2] * r, v[3] * r); o.z = cvtpk(v[4] * r, v[5] * r); o.w = cvtpk(v[6] * r, v[7] * r);
        *(GAS v4u*)p = o;
    }
}
__device__ __forceinline__ void mix_phase(Frame& F, int layer, const float* rel_bias, const float* kvg) {
    LAS float* lut = (LAS float*)(F.lds + L_LUT); LAS float* gtab = (LAS float*)(F.lds + L_G);
    for (int i = F.tid; i < 129 * 8; i += 512) { const int nd = i >> 3, h = i & 7; int bk;
        if (nd < 16) bk = nd; else { bk = 16 + (int)(logf((float)nd / 16.0f) / logf(8.0f) * 16.0f); bk = bk > 31 ? 31 : bk; }
        lut[i] = rel_bias[bk * 8 + h] * 1.44269504f; }
    if (F.tid < 128) gtab[F.tid] = kvg[F.tid];
    __syncthreads();
#pragma unroll 1
    for (int it = 2 * F.vcu; it < 2048; ++it) { const int p = it >> 1, b = p >> 7, jj = p & 127; mix_unit(F, layer, b, (it & 1) ? 255 - jj : jj); if (it & 1) it += 2 * F.G - 2; }
    __syncthreads();
}
}

struct Args { const float* in[17]; float* out; unsigned char* ws; int ph_lo, ph_hi; };
static_assert(sizeof(Args) == 17 * 8 + 8 + 8 + 8, "Args has no padding");
#if MK_PER_PHASE
#define GRID_BAR() do { } while (0)
#else
#define GRID_BAR() xcd_barrier(bar)
#endif
#define IN(k) (lo <= (k) && (k) < hi)
#define SEAM(k) do { if (IN((k) + 1)) GRID_BAR(); } while (0)
template <int L>
__device__ __forceinline__ void run_layer(Frame& F, const XcdBarrier& bar, const int lo, const int hi, const float* rel_bias, const float* kvg, const float* ln1g, const float* ln1b, const float* ln2g, const float* ln2b) {
    constexpr int pb = 1 + 8 * L;
    bf16* XN = (bf16*)(F.ws + WS_XN); bf16* PROJ = (bf16*)(F.ws + WS_PROJ); bf16* MIX = (bf16*)(F.ws + WS_MIX); bf16* HB = (bf16*)(F.ws + WS_H);
#ifndef DBG_NO_GEMM
    if (IN(pb + 0)) {
        pg8::Gemm g{XN, (const bf16*)(F.ws + WS_WIN) + (size_t)L * NP * D, M, NP, D}; pg8::StaticOrder S; S.init(M, NP, F.G, (int)blockIdx.x);
        pg8::EpiProj E{PROJ, NP};
        pg8::gemm_phase<pg8::EpiProj, pg8::StaticOrder, PG8_ALIGN, PG8_SP2>(F.lds + L_MAIN, g, S, E);
        SEAM(pb + 0);
    }
#endif
#ifndef DBG_NO_MIX
    if (IN(pb + 1)) { mixp::cnorm_phase(F); SEAM(pb + 1); }
    if (IN(pb + 2)) {
#if (DBG_REP & 2)
        mixp::mix_phase(F, L, rel_bias, kvg); GRID_BAR();
#endif
        mixp::mix_phase(F, L, rel_bias, kvg); SEAM(pb + 2); }
#endif
#ifndef DBG_NO_GEMM
    if (IN(pb + 3)) {
        pg8::Gemm g{MIX, (const bf16*)(F.ws + WS_WO) + (size_t)L * D * KO, M, D, KO}; pg8::StaticOrder S; S.init(M, D, F.G, (int)blockIdx.x);
        pg8::EpiRes E{XN, D, ALPHA};
        pg8::gemm_phase<pg8::EpiRes, pg8::StaticOrder, PG8_ALIGN, PG8_SP2>(F.lds + L_MAIN, g, S, E);
        SEAM(pb + 3);
    }
    if (IN(pb + 4)) { ln_phase(F, ln1g, ln1b, false); SEAM(pb + 4); }
    if (IN(pb + 5)) {
        pg8::Gemm g{XN, (const bf16*)(F.ws + WS_WUP) + (size_t)L * FF * D, M, FF, D}; pg8::StaticOrder S; S.init(M, FF, F.G, (int)blockIdx.x);
        pg8::EpiRelu2 E{HB, FF};
#if (DBG_REP & 4)
        pg8::gemm_phase<pg8::EpiRelu2, pg8::StaticOrder, PG8_ALIGN, PG8_SP2>(F.lds + L_MAIN, g, S, E); GRID_BAR();
#endif
        pg8::gemm_phase<pg8::EpiRelu2, pg8::StaticOrder, PG8_ALIGN, PG8_SP2>(F.lds + L_MAIN, g, S, E);
        SEAM(pb + 6);
    }
    if (IN(pb + 6)) {
        pg8::Gemm g{HB, (const bf16*)(F.ws + WS_WDN) + (size_t)L * D * FF, M, D, FF}; pg8::StaticOrder S; S.init(M, D, F.G, (int)blockIdx.x);
        pg8::EpiRes E{XN, D, ALPHA};
        pg8::gemm_phase<pg8::EpiRes, pg8::StaticOrder, PG8_ALIGN, PG8_SP2>(F.lds + L_MAIN, g, S, E);
        SEAM(pb + 6);
    }
#endif
    if (IN(pb + 7)) { ln_phase(F, ln2g, ln2b, L + 1 == NLAYER); if (L + 1 < NLAYER) SEAM(pb + 7); }
}
__global__ void __launch_bounds__(NWAVES * 64, 2) hymba_fwd(Args args) {
    extern __shared__ __attribute__((aligned(16))) unsigned char lds[];
    Frame F;
    F.lds = (LAS unsigned char*)lds;
    F.tid = threadIdx.x; F.lane = F.tid & 63; F.wave = __builtin_amdgcn_readfirstlane(F.tid >> 6);
    F.G = gridDim.x; { const int bx = blockIdx.x; F.vcu = (F.G % 8 == 0) ? (bx % 8) * (F.G / 8) + bx / 8 : bx; }
    F.out = args.out; F.ws = args.ws;
    volatile LAS unsigned* MISC = (volatile LAS unsigned*)(F.lds + L_MISC);
    if (F.tid < 32) MISC[F.tid] = 0u;
    __syncthreads();
    XcdBarrier bar; bar.bar = (unsigned*)(F.ws + WS_CTL) + CW_BAR; bar.x = 0; bar.st = nullptr;
#if !MK_PER_PHASE
    bar = xcd_barrier_post((unsigned*)(F.ws + WS_CTL) + CW_BAR, MISC + 8);
#endif
    const int lo = args.ph_lo, hi = args.ph_hi;
#ifndef DBG_NO_PRO
    if (IN(0)) {
#if (DBG_REP & 1)
        p0_prologue(F, args.in[0], args.in[1], args.in[2], args.in[4], args.in[5], args.in[6], args.in[8], args.in[9], args.in[10], args.in[13], args.in[14], DBG_PMASK); GRID_BAR();
#endif
        p0_prologue(F, args.in[0], args.in[1], args.in[2], args.in[4], args.in[5], args.in[6], args.in[8], args.in[9], args.in[10], args.in[13], args.in[14]); SEAM(0); }
#endif
    run_layer<0>(F, bar, lo, hi, args.in[3], args.in[7], args.in[11], args.in[12], args.in[15], args.in[16]);
    run_layer<1>(F, bar, lo, hi, args.in[3], args.in[7] + 128, args.in[11] + D, args.in[12] + D, args.in[15] + D, args.in[16] + D);
}
#undef IN
#undef SEAM
#undef GRID_BAR

extern "C" void kernel_launch(void* const* d_in, const int* in_sizes, int n_in, void* d_out, int out_size, void* d_ws, size_t ws_size, hipStream_t stream) {
    static int grid = 0;
    if (grid == 0) {
        if (n_in != 17 || in_sizes[0] != M * D || out_size != M * D || ws_size < WS_END) { fprintf(stderr, "kernel_launch: unexpected shapes (n_in %d, in0 %d, out %d, ws %zu)\n", n_in, n_in > 0 ? in_sizes[0] : -1, out_size, ws_size); grid = -1; return; }
        int dev = 0, cus = 0, per_cu = 0;
        if (hipGetDevice(&dev) != hipSuccess || hipDeviceGetAttribute(&cus, hipDeviceAttributeMultiprocessorCount, dev) != hipSuccess) { grid = -1; return; }
        if (hipFuncSetAttribute((const void*)hymba_fwd, hipFuncAttributeMaxDynamicSharedMemorySize, LDS_BYTES) != hipSuccess) { fprintf(stderr, "kernel_launch: hipFuncSetAttribute failed\n"); grid = -1; return; }
        if (hipOccupancyMaxActiveBlocksPerMultiprocessor(&per_cu, (const void*)hymba_fwd, NWAVES * 64, LDS_BYTES) != hipSuccess || per_cu < 1) { fprintf(stderr, "kernel_launch: occupancy query says %d blocks per CU\n", per_cu); per_cu = 1; }
        (void)hipGetLastError();
        grid = cus;
    }
    if (grid < 0) return;
    (void)hipMemsetAsync((char*)d_ws + WS_CTL, 0, CTL_ZERO_BYTES, stream);
    Args a{};
    for (int i = 0; i < 17; ++i) a.in[i] = (const float*)d_in[i];
    a.out = (float*)d_out; a.ws = (unsigned char*)d_ws;
#if MK_PER_PHASE
    for (int p = 0; p < N_PHASES; ++p) { a.ph_lo = p; a.ph_hi = p + 1; hipLaunchKernelGGL(hymba_fwd, dim3(grid), dim3(NWAVES * 64), LDS_BYTES, stream, a); }
#else
    a.ph_lo = 0; a.ph_hi = N_PHASES;
    hipLaunchKernelGGL(hymba_fwd, dim3(grid), dim3(NWAVES * 64), LDS_BYTES, stream, a);
#endif
    const hipError_t le = hipPeekAtLastError();
    if (le != hipSuccess) fprintf(stderr, "kernel_launch: launch failed: %s\n", hipGetErrorName(le));
}
```

```cpp
#define MK_PER_PHASE 0
#ifndef DBG_PMASK
#define DBG_PMASK 31
#endif
#ifndef DBG_SKIP
#define DBG_SKIP 0
#endif
#ifndef DBG_REPM
#define DBG_REPM 0
#endif
#ifndef DBG_REP
#define DBG_REP 0
#endif
#include <hip/hip_runtime.h>
#include <cstdio>
#include <cstdint>
namespace pg8 {
#define PG8_LAS __attribute__((address_space(3)))
typedef unsigned short bf16_t;
typedef short bf16x8 __attribute__((ext_vector_type(8)));
typedef float f32x4 __attribute__((ext_vector_type(4)));
typedef unsigned u32x4 __attribute__((ext_vector_type(4)));
constexpr int BM = 256, BK = 64, HALF = 128, HTB = HALF * BK * 2  , STAGE_BYTES = 8 * HTB, NXCD = 8, WGM = 8;

__host__ __device__ __forceinline__ int lds_byte(int r, int c) { const int st = (r >> 4) * 2 + (c >> 5), rr = r & 15, cc = c & 31, ob = rr * 64 + cc * 2; return st * 1024 + (ob ^ (((ob >> 9) & 1) << 5)); }
__host__ __device__ __forceinline__ void stage_rc(int b, int& R, int& C) { const int st = b / 1024, sb = b % 1024, swz = sb ^ (((sb >> 9) & 1) << 5); R = (st >> 1) * 16 + swz / 64; C = (st & 1) * 32 + (swz % 64) / 2; }
__host__ __device__ __forceinline__ int perm32(int rho) { const int n = rho >> 4, i = rho & 15; return 8 * (i >> 2) + 4 * n + (i & 3); }

struct Unit { int pm, pn; };
struct Gemm { const bf16_t* A; const bf16_t* Bt; int M, N, K; };

struct StaticOrder {
    int nM, nN, nwg, G, c;
    __host__ __device__ void init(int M, int N, int G_, int c_) { nM = M / BM; nN = N / BM; nwg = nM * nN; G = G_; c = c_; }
    __host__ __device__ bool next(int i, Unit& u) const {
        const long L = (long)i * G + c; if (L >= nwg) return false;
        int wgid = (int)L; { const int q = nwg / NXCD, r = nwg % NXCD, xcd = wgid % NXCD, off = wgid / NXCD; wgid = (xcd < r ? xcd * (q + 1) : r * (q + 1) + (xcd - r) * q) + off; }
        const int nig = WGM * nN, gid = wgid / nig, fm = gid * WGM, gsz = (nM - fm) < WGM ? (nM - fm) : WGM;
        u.pm = fm + ((wgid % nig) % gsz); u.pn = (wgid % nig) / gsz; return true;
    }
    __device__ __forceinline__ void a_ready(const Unit&) const {}
    __device__ __forceinline__ void done(const Unit&) const {}
};

__device__ __forceinline__ unsigned cvt_pk_bf16(float lo, float hi) { unsigned r; asm volatile("v_cvt_pk_bf16_f32 %0, %1, %2" : "=v"(r) : "v"(lo), "v"(hi)); return r; }

struct EpiProj {
    static constexpr bool PERM = true, AFTER_DRAIN = false;
    bf16_t* O; int ldc;
    __device__ __forceinline__ void operator()(const f32x4 (&acc)[2][2][4][2], const Unit& u, int wr, int wc, int fr, int fq) const {
        const int row0 = u.pm * BM + wr * 64 + fr, col0 = u.pn * BM + wc * 32 + 8 * fq;
#pragma unroll
        for (int ai = 0; ai < 2; ++ai)
#pragma unroll
            for (int m = 0; m < 4; ++m) { bf16_t* rowp = O + (size_t)(row0 + ai * HALF + m * 16) * ldc + col0;
#pragma unroll
                for (int bj = 0; bj < 2; ++bj) { const f32x4 v0 = acc[ai][bj][m][0], v1 = acc[ai][bj][m][1];
                    u32x4 w; w.x = cvt_pk_bf16(v0[0], v0[1]); w.y = cvt_pk_bf16(v0[2], v0[3]); w.z = cvt_pk_bf16(v1[0], v1[1]); w.w = cvt_pk_bf16(v1[2], v1[3]);
                    *(u32x4*)(rowp + bj * HALF) = w; } }
    }
};
struct EpiRes {
    static constexpr bool PERM = true, AFTER_DRAIN = false;
    bf16_t* X; int ldc; float alpha;
    __device__ __forceinline__ void operator()(const f32x4 (&acc)[2][2][4][2], const Unit& u, int wr, int wc, int fr, int fq) const {
        const int row0 = u.pm * BM + wr * 64 + fr, col0 = u.pn * BM + wc * 32 + 8 * fq;
#pragma unroll
        for (int ai = 0; ai < 2; ++ai)
#pragma unroll
            for (int m = 0; m < 4; ++m) { bf16_t* rowp = X + (size_t)(row0 + ai * HALF + m * 16) * ldc + col0;
                u32x4 xin[2];
#pragma unroll
                for (int bj = 0; bj < 2; ++bj) xin[bj] = *(const u32x4*)(rowp + bj * HALF);
#pragma unroll
                for (int bj = 0; bj < 2; ++bj) { const f32x4 v0 = acc[ai][bj][m][0], v1 = acc[ai][bj][m][1]; const u32x4 x = xin[bj];
#define PG8_LO(w) __builtin_bit_cast(float, (w) << 16)
#define PG8_HI(w) __builtin_bit_cast(float, (w) & 0xffff0000u)
                    u32x4 w; w.x = cvt_pk_bf16(PG8_LO(x.x) * alpha + v0[0], PG8_HI(x.x) * alpha + v0[1]); w.y = cvt_pk_bf16(PG8_LO(x.y) * alpha + v0[2], PG8_HI(x.y) * alpha + v0[3]);
                    w.z = cvt_pk_bf16(PG8_LO(x.z) * alpha + v1[0], PG8_HI(x.z) * alpha + v1[1]); w.w = cvt_pk_bf16(PG8_LO(x.w) * alpha + v1[2], PG8_HI(x.w) * alpha + v1[3]);
#undef PG8_LO
#undef PG8_HI
                    *(u32x4*)(rowp + bj * HALF) = w; }
                asm volatile("" ::: "memory"); }
    }
};
struct EpiRelu2 {
    static constexpr bool PERM = true, AFTER_DRAIN = false;
    bf16_t* O; int ldc;
    __device__ __forceinline__ void operator()(const f32x4 (&acc)[2][2][4][2], const Unit& u, int wr, int wc, int fr, int fq) const {
        const int row0 = u.pm * BM + wr * 64 + fr, col0 = u.pn * BM + wc * 32 + 8 * fq;
#pragma unroll
        for (int ai = 0; ai < 2; ++ai)
#pragma unroll
            for (int m = 0; m < 4; ++m) { bf16_t* rowp = O + (size_t)(row0 + ai * HALF + m * 16) * ldc + col0;
#pragma unroll
                for (int bj = 0; bj < 2; ++bj) { f32x4 v0 = acc[ai][bj][m][0], v1 = acc[ai][bj][m][1];
#pragma unroll
                    for (int j = 0; j < 4; ++j) { const float a = fmaxf(v0[j], 0.f), b = fmaxf(v1[j], 0.f); v0[j] = a * a; v1[j] = b * b; }
                    u32x4 w; w.x = cvt_pk_bf16(v0[0], v0[1]); w.y = cvt_pk_bf16(v0[2], v0[3]); w.z = cvt_pk_bf16(v1[0], v1[1]); w.w = cvt_pk_bf16(v1[2], v1[3]);
                    *(u32x4*)(rowp + bj * HALF) = w; } }
    }
};

template <class Epi, class Sched, bool ALIGN_EPI = false, bool SP2 = false>
__device__ __forceinline__ void gemm_phase(PG8_LAS unsigned char* lds, const Gemm g, const Sched& S, const Epi& E) {
    const int tid = threadIdx.x, wid = __builtin_amdgcn_readfirstlane(tid >> 6), lane = tid & 63, wr = wid >> 2, wc = wid & 3, fr = lane & 15, fq = lane >> 4;
    const int K = g.K, nt = K / BK;
    unsigned voffA[2], voffB[2];
#pragma unroll
    for (int i = 0; i < 2; ++i) { int R, C; stage_rc(tid * 16 + i * 8192, R, C); const int Rb = Epi::PERM ? ((R & ~31) + perm32(R & 31)) : R;
        voffA[i] = (unsigned)(R * K + C) * 2u; voffB[i] = (unsigned)(Rb * K + C) * 2u; }
    const size_t kstep = (size_t)(BK * 2);
    const size_t hstep = (size_t)HALF * K * 2;
    const size_t tstep = 2 * hstep;
    const unsigned ldsw = (unsigned)wid * 1024u;
    const int aoff = lds_byte(wr * 64 + fr, fq * 8), boff = lds_byte(wc * 32 + fr, fq * 8);
#define PG8_SA(b, h) (((b) * 2 + (h)) * HTB)
#define PG8_SB(b, h) ((4 + (b) * 2 + (h)) * HTB)
#define PG8_STAGE(bufoff, gbase, voff) do { _Pragma("unroll") for (int _i = 0; _i < 2; ++_i) \
        __builtin_amdgcn_global_load_lds((const unsigned*)((const char*)(gbase) + (voff)[_i]), (PG8_LAS unsigned*)(lds + (bufoff) + ldsw + _i * 8192), 16, 0, 0); } while (0)
#define PG8_LDA(dst, b, h) do { _Pragma("unroll") for (int m = 0; m < 4; ++m) _Pragma("unroll") for (int k = 0; k < 2; ++k) dst[m][k] = *(const PG8_LAS bf16x8*)(lds + PG8_SA(b, h) + aoff + m * 2048 + k * 1024); } while (0)
#define PG8_LDB(dst, b, h) do { _Pragma("unroll") for (int n = 0; n < 2; ++n) _Pragma("unroll") for (int k = 0; k < 2; ++k) dst[n][k] = *(const PG8_LAS bf16x8*)(lds + PG8_SB(b, h) + boff + n * 2048 + k * 1024); } while (0)
#define PG8_MMA(ai, bj, At, Bt) do { __builtin_amdgcn_s_setprio(1); _Pragma("unroll") for (int m = 0; m < 4; ++m) _Pragma("unroll") for (int n = 0; n < 2; ++n) _Pragma("unroll") for (int k = 0; k < 2; ++k) \
        acc[ai][bj][m][n] = __builtin_amdgcn_mfma_f32_16x16x32_bf16(Bt[n][k], At[m][k], acc[ai][bj][m][n], 0, 0, 0); __builtin_amdgcn_s_setprio(0); } while (0)
#define PG8_WAIT_V(n) asm volatile("s_waitcnt vmcnt(" #n ")" ::: "memory")
#define PG8_WAIT_L(n) asm volatile("s_waitcnt lgkmcnt(" #n ")" ::: "memory")
#define PG8_BAR __builtin_amdgcn_s_barrier()
#define PG8_SCHED __builtin_amdgcn_sched_barrier(0)
    Unit cur, nxt; int ui = 0;
    if (!S.next(0, cur)) return;
    f32x4 acc[2][2][4][2];
#pragma unroll
    for (int a = 0; a < 2; ++a)
#pragma unroll
        for (int b = 0; b < 2; ++b)
#pragma unroll
            for (int m = 0; m < 4; ++m)
#pragma unroll
                for (int n = 0; n < 2; ++n) acc[a][b][m][n] = (f32x4){0.f, 0.f, 0.f, 0.f};
    bf16x8 At[4][2], B0[2][2], B1[2][2];
    const char* cA = (const char*)g.A + (size_t)cur.pm * tstep; const char* cB = (const char*)g.Bt + (size_t)cur.pn * tstep;
    S.a_ready(cur);
    if constexpr (SP2) {
        PG8_STAGE(PG8_SB(0, 0), cB, voffB); PG8_STAGE(PG8_SB(0, 1), cB + hstep, voffB); PG8_STAGE(PG8_SA(0, 0), cA, voffA); PG8_STAGE(PG8_SA(0, 1), cA + hstep, voffA);
        if (wr == 1) PG8_BAR;
        PG8_WAIT_V(2); PG8_BAR;
        PG8_STAGE(PG8_SB(1, 0), cB + kstep, voffB); PG8_STAGE(PG8_SA(1, 0), cA + kstep, voffA); PG8_STAGE(PG8_SB(1, 1), cB + hstep + kstep, voffB);
        PG8_WAIT_V(6); PG8_BAR;
    } else {
        PG8_STAGE(PG8_SB(0, 0), cB, voffB); PG8_STAGE(PG8_SA(0, 0), cA, voffA); PG8_STAGE(PG8_SB(0, 1), cB + hstep, voffB); PG8_STAGE(PG8_SA(0, 1), cA + hstep, voffA);
        if (wr == 1) PG8_BAR;
        PG8_WAIT_V(4); PG8_BAR;
        PG8_STAGE(PG8_SB(1, 0), cB + kstep, voffB); PG8_STAGE(PG8_SA(1, 0), cA + kstep, voffA); PG8_STAGE(PG8_SB(1, 1), cB + hstep + kstep, voffB);
        PG8_WAIT_V(6); PG8_BAR;
    }
    for (;;) {
        const bool has_next = S.next(ui + 1, nxt);
        const char* nA = has_next ? (const char*)g.A + (size_t)nxt.pm * tstep : cA; const char* nB = has_next ? (const char*)g.Bt + (size_t)nxt.pn * tstep : cB;
        for (int t = 0; t < nt; t += 2) {
            const bool last = (t == nt - 2);
            const char* a1 = cA + (size_t)(t + 1) * kstep;
            const char* a2 = last ? nA : cA + (size_t)(t + 2) * kstep; const char* b2 = last ? nB : cB + (size_t)(t + 2) * kstep;
            const char* a3 = a2 + kstep; const char* b3 = b2 + kstep;
            if (last && has_next) S.a_ready(nxt);
            if constexpr (SP2) {
            PG8_LDB(B0, 0, 0); PG8_LDB(B1, 0, 1); PG8_SCHED; PG8_LDA(At, 0, 0); PG8_STAGE(PG8_SA(1, 1), a1 + hstep, voffA);
            PG8_WAIT_V(8); PG8_WAIT_L(0); PG8_BAR; PG8_MMA(0, 0, At, B0); PG8_MMA(0, 1, At, B1); PG8_BAR; PG8_SCHED;
            PG8_LDA(At, 0, 1); PG8_STAGE(PG8_SB(0, 0), b2, voffB); PG8_STAGE(PG8_SB(0, 1), b2 + hstep, voffB); PG8_STAGE(PG8_SA(0, 0), a2, voffA);
            PG8_WAIT_V(8); PG8_WAIT_L(0); PG8_BAR; PG8_MMA(1, 0, At, B0); PG8_MMA(1, 1, At, B1); PG8_BAR; PG8_SCHED;
            PG8_LDB(B0, 1, 0); PG8_LDB(B1, 1, 1); PG8_SCHED; PG8_LDA(At, 1, 0); PG8_STAGE(PG8_SA(0, 1), a2 + hstep, voffA);
            PG8_WAIT_V(8); PG8_WAIT_L(0); PG8_BAR; PG8_MMA(0, 0, At, B0); PG8_MMA(0, 1, At, B1); PG8_BAR; PG8_SCHED;
            PG8_LDA(At, 1, 1); PG8_STAGE(PG8_SB(1, 0), b3, voffB); PG8_STAGE(PG8_SB(1, 1), b3 + hstep, voffB); PG8_STAGE(PG8_SA(1, 0), a3, voffA);
            PG8_WAIT_V(8); PG8_WAIT_L(0); PG8_BAR; PG8_MMA(1, 0, At, B0); PG8_MMA(1, 1, At, B1); PG8_BAR; PG8_SCHED;
            } else {
            PG8_LDB(B0, 0, 0); PG8_SCHED; PG8_LDA(At, 0, 0); PG8_STAGE(PG8_SA(1, 1), a1 + hstep, voffA);
            PG8_WAIT_L(8); PG8_BAR; PG8_WAIT_L(0); PG8_MMA(0, 0, At, B0); PG8_BAR; PG8_SCHED;
            PG8_LDB(B1, 0, 1); PG8_STAGE(PG8_SB(0, 0), b2, voffB);
            PG8_BAR; PG8_WAIT_L(0); PG8_MMA(0, 1, At, B1); PG8_BAR;
            PG8_LDA(At, 0, 1); PG8_STAGE(PG8_SA(0, 0), a2, voffA);
            PG8_BAR; PG8_WAIT_L(0); PG8_MMA(1, 0, At, B0); PG8_BAR; PG8_SCHED;
            PG8_STAGE(PG8_SB(0, 1), b2 + hstep, voffB);
            PG8_WAIT_V(6); PG8_BAR; PG8_MMA(1, 1, At, B1); PG8_BAR;
            PG8_LDB(B0, 1, 0); PG8_SCHED; PG8_LDA(At, 1, 0); PG8_STAGE(PG8_SA(0, 1), a2 + hstep, voffA);
            PG8_WAIT_L(8); PG8_BAR; PG8_WAIT_L(0); PG8_MMA(0, 0, At, B0); PG8_BAR; PG8_SCHED;
            PG8_LDB(B1, 1, 1); PG8_STAGE(PG8_SB(1, 0), b3, voffB);
            PG8_BAR; PG8_WAIT_L(0); PG8_MMA(0, 1, At, B1); PG8_BAR;
            PG8_LDA(At, 1, 1); PG8_STAGE(PG8_SA(1, 0), a3, voffA);
            PG8_BAR; PG8_WAIT_L(0); PG8_MMA(1, 0, At, B0); PG8_BAR; PG8_SCHED;
            PG8_STAGE(PG8_SB(1, 1), b3 + hstep, voffB);
            PG8_WAIT_V(6); PG8_BAR; PG8_MMA(1, 1, At, B1); PG8_BAR;
            }
        }
        if constexpr (ALIGN_EPI) { if (wr == 0) PG8_BAR; }
        if constexpr (!Epi::AFTER_DRAIN) { E(acc, cur, wr, wc, fr, fq); S.done(cur); }
        if (!has_next) break;
#pragma unroll
        for (int a = 0; a < 2; ++a)
#pragma unroll
            for (int b = 0; b < 2; ++b)
#pragma unroll
                for (int m = 0; m < 4; ++m)
#pragma unroll
                    for (int n = 0; n < 2; ++n) acc[a][b][m][n] = (f32x4){0.f, 0.f, 0.f, 0.f};
        cur = nxt; cA = nA; cB = nB; ++ui;
        if constexpr (ALIGN_EPI) { if (wr == 1) PG8_BAR; }
    }
    PG8_WAIT_V(0);
    if constexpr (!ALIGN_EPI) { if (wr == 0) PG8_BAR; }
    PG8_BAR;
    if constexpr (Epi::AFTER_DRAIN) { E.fused(acc, cur, wr, wc, fr, fq, lds, wid, lane); S.done(cur); }
#undef PG8_SA
#undef PG8_SB
#undef PG8_STAGE
#undef PG8_LDA
#undef PG8_LDB
#undef PG8_MMA
#undef PG8_WAIT_V
#undef PG8_WAIT_L
#undef PG8_BAR
#undef PG8_SCHED
}
}
#ifndef PG8_SP2
#define PG8_SP2 true
#endif
#ifndef PG8_ALIGN
#define PG8_ALIGN true
#endif
constexpr int NWAVES = 8;
#ifndef MK_PER_PHASE
#define MK_PER_PHASE 0
#endif

constexpr int BATCH = 8, SEQ = 4096, D = 1024, M = BATCH * SEQ, DIN = 1736, NP = 1792, FF = 4096, KO = 1536, NLAYER = 2;
constexpr int COL_Q = 512, COL_C = 1024, COL_IQ = 1152, COL_IK = 1664, COL_IW = 1728;
constexpr float ALPHA = 1.4142135623730951f, LN_EPS = 1e-5f;
constexpr int N_PHASES = 1 + 8 * NLAYER;

constexpr size_t MiB = 1u << 20;
constexpr size_t WS_CTL = 0, CTL_ZERO_BYTES = 1 * MiB;
constexpr size_t WS_SS = 47 * MiB;
constexpr size_t WS_WIN = 1 * MiB;
constexpr size_t WS_WO = 8 * MiB;
constexpr size_t WS_WUP = 14 * MiB;
constexpr size_t WS_WDN = 30 * MiB;
constexpr size_t WS_WUK = 46 * MiB;
constexpr size_t WS_XN = 48 * MiB;
constexpr size_t WS_PROJ = 112 * MiB;
constexpr size_t WS_MIX = 224 * MiB;
constexpr size_t WS_H = 112 * MiB;
constexpr size_t WS_END = 368 * MiB;
static_assert(WS_WIN + (size_t)NLAYER * NP * D * 2 <= WS_WO && WS_WO + (size_t)NLAYER * D * KO * 2 <= WS_WUP && WS_WUP + (size_t)NLAYER * FF * D * 2 <= WS_WDN &&
              WS_WDN + (size_t)NLAYER * D * FF * 2 <= WS_WUK && WS_WUK + (size_t)NLAYER * 128 * 512 * 2 <= WS_XN && WS_XN + (size_t)M * D * 2 <= WS_PROJ &&
              WS_PROJ + (size_t)M * NP * 2 <= WS_MIX && WS_MIX + (size_t)M * KO * 2 <= WS_H + (size_t)M * FF * 2 && WS_H + (size_t)M * FF * 2 <= WS_END, "d_ws map");
constexpr int CW_BAR = 4096;

constexpr int L_MAIN = 0;
constexpr int L_SEL = 131072;
constexpr int L_WH = L_SEL + 8192;
constexpr int L_SS = L_WH + 4096;
constexpr int L_LUT = L_SS + 2048;
constexpr int L_CNT = L_LUT + 4352;
constexpr int L_CCNT = L_CNT + 128;
constexpr int L_THR1 = L_CCNT + 128, L_NEED1 = L_THR1 + 128;
constexpr int L_RBUF = L_NEED1 + 128;
constexpr int L_G = L_RBUF + 1024;
constexpr int L_BM = L_G + 512;
constexpr int L_MISC = L_BM + 8192;
constexpr int LDS_BYTES = L_MISC + 128;
static_assert(LDS_BYTES <= 163840 && LDS_BYTES > 81920, "LDS map (more than half of the CU's LDS: exactly one workgroup per CU)");

#define GAS __attribute__((address_space(1)))
#define LAS __attribute__((address_space(3)))
typedef unsigned short bf16;
typedef unsigned v4u __attribute__((ext_vector_type(4)));
typedef float f32x4 __attribute__((ext_vector_type(4)));
typedef short bf16x8 __attribute__((ext_vector_type(8)));
typedef GAS unsigned gu32;
typedef GAS unsigned long long gu64;
#define RLX_AGENT __ATOMIC_RELAXED, __HIP_MEMORY_SCOPE_AGENT
#define LDS_WAIT() asm volatile("s_waitcnt lgkmcnt(0)" ::: "memory")
#define VM_WAIT() asm volatile("s_waitcnt vmcnt(0)" ::: "memory")
__device__ __forceinline__ unsigned long long rt() { return __builtin_amdgcn_s_memrealtime(); }
__device__ __forceinline__ unsigned f2bf(float f) { unsigned u = __builtin_bit_cast(unsigned, f); return (u + 0x7fffu + ((u >> 16) & 1u)) >> 16; }
__device__ __forceinline__ unsigned pk2(float lo, float hi) { return f2bf(lo) | (f2bf(hi) << 16); }
#define XB_TMO      128
#define XB_XCNT(j)  (256  + 64 * (j))
#define XB_XSUB(j)  (1280 + 64 * (j))
#define XB_XGEN(j)  (2304 + 64 * (j))
#define XB_TOP      3328
#define XB_TOPGEN   3392
#define XCD_BAR_WORDS 3456
#define XB_SPIN_CAP (1u << 18)

__device__ __forceinline__ unsigned xb_ld(unsigned* p)              { return __hip_atomic_load(p, __ATOMIC_RELAXED, __HIP_MEMORY_SCOPE_AGENT); }
__device__ __forceinline__ unsigned xb_add(unsigned* p, unsigned v) { return __hip_atomic_fetch_add(p, v, __ATOMIC_RELAXED, __HIP_MEMORY_SCOPE_AGENT); }
__device__ __forceinline__ unsigned xb_xcc_id() { return (unsigned)__builtin_amdgcn_s_getreg((3 << 11) | 20) & 0xFu; }
#define XB_SPIN(cond, bar) do { unsigned _sp = 0; while (cond) { __builtin_amdgcn_s_sleep(1); \
    if ((++_sp & 255u) == 0u) { if (xb_ld(&(bar)[XB_TMO])) break; if (_sp > XB_SPIN_CAP) { atomicAdd(&(bar)[XB_TMO], 1u); break; } } } } while (0)

struct XcdBarrier {
    unsigned* bar; unsigned x;
    volatile LAS unsigned* st;
};

__device__ __forceinline__ XcdBarrier xcd_barrier_post(unsigned* bar, volatile LAS unsigned* st) {
    XcdBarrier b; b.bar = bar; b.x = xb_xcc_id(); b.st = st;
    if (threadIdx.x == 0) (void)xb_add(&bar[XB_XCNT(b.x)], 1u);
    return b;
}
__device__ __forceinline__ void xcd_barrier_complete(unsigned* bar, unsigned x, unsigned& nloc, unsigned& nx) {
    const unsigned G = gridDim.x * gridDim.y * gridDim.z;
    unsigned sum, cnt, mine, sp = 0u;
    for (;;) {
        sum = 0u; cnt = 0u; mine = 0u;
#pragma unroll
        for (unsigned j = 0; j < 16; ++j) { const unsigned c = xb_ld(&bar[XB_XCNT(j)]); sum += c; cnt += (c > 0u) ? 1u : 0u; mine = (j == x) ? c : mine; }
        if (sum == G) break;
        __builtin_amdgcn_s_sleep(1);
        if ((++sp & 255u) == 0u) { if (xb_ld(&bar[XB_TMO])) break; if (sp > XB_SPIN_CAP) { atomicAdd(&bar[XB_TMO], 1u); break; } }
    }
    nloc = mine > 0u ? mine : 1u; nx = cnt > 0u ? cnt : 1u;
}

__device__ __forceinline__ void xcd_barrier(const XcdBarrier& b) {
    asm volatile("s_waitcnt vmcnt(0)" ::: "memory");
    __syncthreads();
    if (threadIdx.x == 0) {
        unsigned* bar = b.bar;
        __builtin_amdgcn_s_waitcnt(0);
        unsigned nloc = b.st[0], nx = b.st[1];
        if (nloc == 0u) { xcd_barrier_complete(bar, b.x, nloc, nx); b.st[0] = nloc; b.st[1] = nx; }
        const unsigned old = xb_add(&bar[XB_XSUB(b.x)], 1u);
        const unsigned gen = old / nloc;
        if (old + 1u == (gen + 1u) * nloc) {
            __builtin_amdgcn_fence(__ATOMIC_RELEASE, "agent");
            asm volatile("s_waitcnt vmcnt(0)" ::: "memory");
            const unsigned og = xb_add(&bar[XB_TOP], 1u);
            const unsigned tg = og / nx;
            if (og + 1u == (tg + 1u) * nx) xb_add(&bar[XB_TOPGEN], 1u);
            else XB_SPIN(xb_ld(&bar[XB_TOPGEN]) == tg, bar);
            __builtin_amdgcn_fence(__ATOMIC_ACQUIRE, "agent");
            xb_add(&bar[XB_XGEN(b.x)], 1u);
            asm volatile("s_waitcnt vmcnt(0)" ::: "memory");
        } else {
            XB_SPIN(xb_ld(&bar[XB_XGEN(b.x)]) == gen, bar);
            __builtin_amdgcn_fence(__ATOMIC_ACQUIRE, "agent");
            asm volatile("s_waitcnt vmcnt(0)" ::: "memory");
        }
    }
    __syncthreads();
}
struct Frame {
    LAS unsigned char* lds;
    int tid, lane, wave;
    int vcu, G;
    float* out;
    unsigned char* ws;
};
typedef float f32x2 __attribute__((ext_vector_type(2)));
__device__ __forceinline__ float wave_sum(float v) {
#pragma unroll
    for (int o = 1; o < 64; o <<= 1) v += __shfl_xor(v, o);
    return v;
}
__device__ __forceinline__ float bf2f(unsigned short v) { return __builtin_bit_cast(float, (unsigned)v << 16); }

__device__ __forceinline__ void tr_item(const float* W, int ldw, int nvalid, bf16* dst, int ldd, LAS float* scr, int lane) {
#pragma unroll 8
    for (int i = 0; i < 32; ++i) { const int kk = 2 * i + (lane >> 5), nn = lane & 31; scr[kk * 33 + nn] = nn < nvalid ? W[(size_t)kk * ldw + nn] : 0.f; }
    LDS_WAIT(); asm volatile("" ::: "memory");
    const int c = lane & 7;
#pragma unroll
    for (int j = 0; j < 4; ++j) { const int n = (lane >> 3) + 8 * j; const LAS float* s = scr + (8 * c) * 33 + n;
        v4u o; o.x = pk2(s[0 * 33], s[1 * 33]); o.y = pk2(s[2 * 33], s[3 * 33]); o.z = pk2(s[4 * 33], s[5 * 33]); o.w = pk2(s[6 * 33], s[7 * 33]);
        *(GAS v4u*)(dst + (size_t)n * ldd + 8 * c) = o; }
    LDS_WAIT(); asm volatile("" ::: "memory");
}
__device__ __forceinline__ void ln_row(const float* xrow, const float* g, const float* b, float* orow, bf16* xn, int lane) {
    const GAS f32x4* xr = (const GAS f32x4*)xrow + lane;
    f32x4 v[4]; float s = 0.f;
#pragma unroll
    for (int j = 0; j < 4; ++j) { v[j] = xr[64 * j]; s += (v[j].x + v[j].y) + (v[j].z + v[j].w); }
    const float mean = wave_sum(s) * (1.f / D); float s2 = 0.f;
#pragma unroll
    for (int j = 0; j < 4; ++j) { v[j] = v[j] - mean; s2 += (v[j].x * v[j].x + v[j].y * v[j].y) + (v[j].z * v[j].z + v[j].w * v[j].w); }
    const float rstd = 1.f / sqrtf(wave_sum(s2) * (1.f / D) + LN_EPS);
    GAS f32x4* o4 = (GAS f32x4*)orow + lane;
#pragma unroll
    for (int j = 0; j < 4; ++j) { const f32x4 gg = ((const GAS f32x4*)g)[lane + 64 * j], bb = ((const GAS f32x4*)b)[lane + 64 * j]; v[j] = v[j] * rstd * gg + bb; if (orow) o4[64 * j] = v[j]; }
    if (xn) { GAS unsigned long long* o8 = (GAS unsigned long long*)xn + lane;
#pragma unroll
        for (int j = 0; j < 4; ++j) o8[64 * j] = (unsigned long long)pk2(v[j].x, v[j].y) | ((unsigned long long)pk2(v[j].z, v[j].w) << 32); }
}
__device__ __forceinline__ void ln_row_b(const bf16* xrow, const float* g, const float* b, float* orow, bf16* xn, int lane) {
    float v[2][8]; float s = 0.f;
#pragma unroll
    for (int j = 0; j < 2; ++j) { const v4u w = *(const GAS v4u*)(xrow + 512 * j + 8 * lane);
        v[j][0] = __builtin_bit_cast(float, w.x << 16); v[j][1] = __builtin_bit_cast(float, w.x & 0xffff0000u); v[j][2] = __builtin_bit_cast(float, w.y << 16); v[j][3] = __builtin_bit_cast(float, w.y & 0xffff0000u);
        v[j][4] = __builtin_bit_cast(float, w.z << 16); v[j][5] = __builtin_bit_cast(float, w.z & 0xffff0000u); v[j][6] = __builtin_bit_cast(float, w.w << 16); v[j][7] = __builtin_bit_cast(float, w.w & 0xffff0000u);
#pragma unroll
        for (int e = 0; e < 8; ++e) s += v[j][e]; }
    const float mean = wave_sum(s) * (1.f / D); float s2 = 0.f;
#pragma unroll
    for (int j = 0; j < 2; ++j)
#pragma unroll
        for (int e = 0; e < 8; ++e) { v[j][e] -= mean; s2 += v[j][e] * v[j][e]; }
    const float rstd = 1.f / sqrtf(wave_sum(s2) * (1.f / D) + LN_EPS);
#pragma unroll
    for (int j = 0; j < 2; ++j) { const GAS f32x4* gp = (const GAS f32x4*)(g + 512 * j + 8 * lane); const GAS f32x4* bp = (const GAS f32x4*)(b + 512 * j + 8 * lane);
        const f32x4 g0 = gp[0], g1 = gp[1], b0 = bp[0], b1 = bp[1];
        f32x4 o0, o1;
#pragma unroll
        for (int e = 0; e < 4; ++e) { o0[e] = v[j][e] * rstd * g0[e] + b0[e]; o1[e] = v[j][4 + e] * rstd * g1[e] + b1[e]; }
        if (orow) { GAS f32x4* op = (GAS f32x4*)(orow + 512 * j + 8 * lane); op[0] = o0; op[1] = o1; }
        else { v4u w; w.x = pk2(o0[0], o0[1]); w.y = pk2(o0[2], o0[3]); w.z = pk2(o1[0], o1[1]); w.w = pk2(o1[2], o1[3]); *(GAS v4u*)(xn + 512 * j + 8 * lane) = w; } }
}
__device__ __forceinline__ void p0_prologue(Frame& F, const float* x_in, const float* emb_g, const float* emb_b, const float* w_in, const float* pool_w, const float* pool_scale,
                                            const float* w_uk, const float* w_uv, const float* w_o, const float* w_up, const float* w_down, const int pmask = 31) {
    LAS float* scr = (LAS float*)(F.lds + L_MAIN + F.wave * 16384);
    const int gw = F.vcu * NWAVES + F.wave, NGW = F.G * NWAVES, lane = F.lane;
    bf16* WIN = (bf16*)(F.ws + WS_WIN); bf16* WO = (bf16*)(F.ws + WS_WO); bf16* WUP = (bf16*)(F.ws + WS_WUP); bf16* WDN = (bf16*)(F.ws + WS_WDN); bf16* WUK = (bf16*)(F.ws + WS_WUK);
    constexpr int I_IN = (D / 64) * 40, I_O = (512 / 64) * (D / 32), I_UP = (D / 64) * (FF / 32), I_DN = (FF / 64) * (D / 32), I_L = I_IN + I_O + I_UP + I_DN;
    if (pmask & 1) for (int it = gw; it < NLAYER * I_L; it += NGW) {
        const int l = it / I_L; int r = it % I_L;
        if (r < I_IN) { const int kb = r / 40, nb = r % 40, n0 = 512 + 32 * nb;
            tr_item(w_in + (size_t)l * D * DIN + (size_t)(64 * kb) * DIN + n0, DIN, DIN - n0, WIN + (size_t)l * NP * D + (size_t)n0 * D + 64 * kb, D, scr, lane); continue; } r -= I_IN;
        if (r < I_O) { const int kb = r / 32, nb = r % 32;
            tr_item(w_o + (size_t)l * D * D + (size_t)(64 * kb) * D + 32 * nb, D, 32, WO + (size_t)l * D * KO + (size_t)(32 * nb) * KO + 64 * kb, KO, scr, lane); continue; } r -= I_O;
        if (r < I_UP) { const int kb = r / 128, nb = r % 128;
            tr_item(w_up + (size_t)l * D * FF + (size_t)(64 * kb) * FF + 32 * nb, FF, 32, WUP + (size_t)l * FF * D + (size_t)(32 * nb) * D + 64 * kb, D, scr, lane); continue; } r -= I_UP;
        { const int kb = r / 32, nb = r % 32;
            tr_item(w_down + (size_t)l * FF * D + (size_t)(64 * kb) * D + 32 * nb, D, 32, WDN + (size_t)l * D * FF + (size_t)(32 * nb) * FF + 64 * kb, FF, scr, lane); }
    }
    if (pmask & 2) for (int it = gw; it < NLAYER * 4 * 64; it += NGW) {
        const int l = it >> 8, g = (it >> 6) & 3, k0 = 16 * (it & 63), mm = lane & 15, g4 = lane >> 4;
        const float* wi = w_in + (size_t)l * D * DIN + (size_t)(k0 + mm) * DIN + g * 128 + 8 * g4; const float* pw = pool_w + ((size_t)(l * 4 + g) * 128) * 128 + mm;
        bf16x8 Af[4];
#pragma unroll
        for (int s = 0; s < 4; ++s) { const f32x4 u0 = *(const GAS f32x4*)(wi + 32 * s), u1 = *(const GAS f32x4*)(wi + 32 * s + 4);
            union { bf16x8 v; unsigned u[4]; } t; t.u[0] = pk2(u0[0], u0[1]); t.u[1] = pk2(u0[2], u0[3]); t.u[2] = pk2(u1[0], u1[1]); t.u[3] = pk2(u1[2], u1[3]); Af[s] = t.v; }
#pragma unroll 2
        for (int db = 0; db < 8; ++db) {
            f32x4 acc = (f32x4){0.f, 0.f, 0.f, 0.f};
#pragma unroll
            for (int s = 0; s < 4; ++s) { float bv[8];
#pragma unroll
                for (int j = 0; j < 8; ++j) bv[j] = pw[(size_t)(32 * s + 8 * g4 + j) * 128 + 16 * db];
                union { bf16x8 v; unsigned u[4]; } t; t.u[0] = pk2(bv[0], bv[1]); t.u[1] = pk2(bv[2], bv[3]); t.u[2] = pk2(bv[4], bv[5]); t.u[3] = pk2(bv[6], bv[7]);
                acc = __builtin_amdgcn_mfma_f32_16x16x32_bf16(Af[s], t.v, acc, 0, 0, 0); }
            const float sc = pool_scale[l * 512 + g * 128 + 16 * db + mm];
            const unsigned long long o = (unsigned long long)pk2(acc[0] * sc, acc[1] * sc) | ((unsigned long long)pk2(acc[2] * sc, acc[3] * sc) << 32);
            *(GAS unsigned long long*)(WIN + (size_t)l * NP * D + (size_t)(g * 128 + 16 * db + mm) * D + k0 + 4 * g4) = o;
        }
    }
    if (pmask & 4) for (int it = gw; it < NLAYER * 8 * 64; it += NGW) {
        const int l = it >> 9, h = (it >> 6) & 7, n0 = 16 * (it & 63), mm = lane & 15, g4 = lane >> 4;
        const float* wo = w_o + (size_t)l * D * D + (size_t)(512 + h * 64 + 8 * g4) * D + n0 + mm; const float* uv = w_uv + (size_t)l * 128 * 512 + (size_t)mm * 512 + h * 64 + 8 * g4;
        bf16x8 Bf[2];
#pragma unroll
        for (int s = 0; s < 2; ++s) { float bv[8];
#pragma unroll
            for (int j = 0; j < 8; ++j) bv[j] = wo[(size_t)(32 * s + j) * D];
            union { bf16x8 v; unsigned u[4]; } t; t.u[0] = pk2(bv[0], bv[1]); t.u[1] = pk2(bv[2], bv[3]); t.u[2] = pk2(bv[4], bv[5]); t.u[3] = pk2(bv[6], bv[7]); Bf[s] = t.v; }
#pragma unroll 2
        for (int cb = 0; cb < 8; ++cb) {
            f32x4 acc = (f32x4){0.f, 0.f, 0.f, 0.f};
#pragma unroll
            for (int s = 0; s < 2; ++s) { const f32x4 u0 = *(const GAS f32x4*)(uv + (size_t)(16 * cb) * 512 + 32 * s), u1 = *(const GAS f32x4*)(uv + (size_t)(16 * cb) * 512 + 32 * s + 4);
                union { bf16x8 v; unsigned u[4]; } t; t.u[0] = pk2(u0[0], u0[1]); t.u[1] = pk2(u0[2], u0[3]); t.u[2] = pk2(u1[0], u1[1]); t.u[3] = pk2(u1[2], u1[3]);
                acc = __builtin_amdgcn_mfma_f32_16x16x32_bf16(t.v, Bf[s], acc, 0, 0, 0); }
            const unsigned long long o = (unsigned long long)pk2(acc[0], acc[1]) | ((unsigned long long)pk2(acc[2], acc[3]) << 32);
            *(GAS unsigned long long*)(WO + (size_t)l * D * KO + (size_t)(n0 + mm) * KO + 512 + h * 128 + 16 * cb + 4 * g4) = o;
        }
    }
    if (pmask & 8) for (int i = gw * 64 + lane; i < NLAYER * 128 * 512; i += NGW * 64) WUK[i] = (bf16)f2bf(w_uk[i] * 0.125f);
    bf16* XN = (bf16*)(F.ws + WS_XN);
    if (pmask & 16) for (int m = gw; m < M; m += NGW) ln_row(x_in + (size_t)m * D, emb_g, emb_b, (float*)nullptr, XN + (size_t)m * D, lane);
}
__device__ __forceinline__ void ln_phase(Frame& F, const float* g, const float* b, bool last) {
    const int gw = F.vcu * NWAVES + F.wave, NGW = F.G * NWAVES; bf16* XN = (bf16*)(F.ws + WS_XN);
    for (int m = gw; m < M; m += NGW) ln_row_b(XN + (size_t)m * D, g, b, last ? F.out + (size_t)m * D : (float*)nullptr, XN + (size_t)m * D, F.lane);
}

namespace mixp {
typedef float f32x4 __attribute__((ext_vector_type(4)));
typedef short bf16x8 __attribute__((ext_vector_type(8)));
typedef unsigned short u16;
typedef unsigned short u16x4 __attribute__((ext_vector_type(4)));
typedef unsigned short u16x8 __attribute__((ext_vector_type(8)));
typedef unsigned u32x2 __attribute__((ext_vector_type(2)));
constexpr int CCAP = 1024;

__device__ __forceinline__ unsigned fkey(float f) { const unsigned b = __builtin_bit_cast(unsigned, f); const unsigned m = (unsigned)((int)b >> 31); return b ^ (m | 0x80000000u); }
__device__ __forceinline__ unsigned off_b(unsigned row, unsigned ch) { return 256u * row + 16u * (ch ^ (((row & 3u) << 2) | ((row >> 2) & 3u))); }
__device__ __forceinline__ unsigned cvtpk(float lo, float hi) { unsigned r; asm volatile("v_cvt_pk_bf16_f32 %0, %1, %2" : "=v"(r) : "v"(lo), "v"(hi)); return r; }

__device__ __forceinline__ void scan_hist(const LAS unsigned* hist, LAS unsigned* S, LAS unsigned* thr_out, LAS unsigned* need_out, int tid) {
    const int q = tid & 15, part = tid >> 4;
    unsigned sum = 0;
#pragma unroll 8
    for (int w = 0; w < 32; ++w) { const u32x2 v = *(const LAS u32x2*)(hist + (part * 32 + w) * 32 + 2 * q); sum += (v.x & 0xffffu) + (v.x >> 16) + (v.y & 0xffffu) + (v.y >> 16); }
    S[part * 16 + q] = sum;
    if (part == 0) { thr_out[q] = 0x7fffffffu; need_out[q] = 0u; }
    __syncthreads();
    const unsigned need = 256u;
    unsigned above = 0;
#pragma unroll 1
    for (int p2 = part + 1; p2 < 32; ++p2) above += S[p2 * 16 + q];
    if (above < need && above + sum >= need) {
#pragma unroll 1
        for (int w = 31; w >= 0; --w) { const u32x2 v = *(const LAS u32x2*)(hist + (part * 32 + w) * 32 + 2 * q); const unsigned hi = (v.x >> 16) + (v.y >> 16), lo = (v.x & 0xffffu) + (v.y & 0xffffu);
            if (above + hi >= need) { thr_out[q] = (unsigned)((part * 32 + w) * 2 + 1); need_out[q] = need - above; break; } above += hi;
            if (above + lo >= need) { thr_out[q] = (unsigned)((part * 32 + w) * 2); need_out[q] = need - above; break; } above += lo; }
    }
    __syncthreads();
}

template <int W, int NT>
__device__ __forceinline__ void pool_filter(const bf16* up, bf16* mp, int ts) {
    unsigned v[W - 1 + NT];
#pragma unroll
    for (int i = 0; i < W - 1 + NT; ++i) { const int t = ts - (W - 1) + i; v[i] = *(const unsigned*)(up + (size_t)(t < 0 ? 0 : t) * NP); if (t < 0) v[i] = 0u; }
    float s0 = 0.f, s1 = 0.f;
#pragma unroll
    for (int i = 0; i < W - 1; ++i) { s0 += bf2f((u16)(v[i] & 0xffff)); s1 += bf2f((u16)(v[i] >> 16)); }
#pragma unroll
    for (int i = 0; i < NT; ++i) { const int t = ts + i; const unsigned cv = v[W - 1 + i]; const float c0 = bf2f((u16)(cv & 0xffff)), c1 = bf2f((u16)(cv >> 16));
        s0 += c0; s1 += c1;
        const float inv = 1.0f / (float)(t + 1 < W ? t + 1 : W);
        *(unsigned*)(mp + (size_t)t * KO) = cvtpk(s0 * inv - c0, s1 * inv - c1);
        s0 -= bf2f((u16)(v[i] & 0xffff)); s1 -= bf2f((u16)(v[i] >> 16)); }
}

__device__ __forceinline__ void mix_unit(Frame& F, int layer, int b, int j) {
    int tid_ = F.tid; asm volatile("" : "+v"(tid_));
    const int tid = tid_, lane = tid & 63, wave = F.wave;
    const bf16* PROJ = (const bf16*)(F.ws + WS_PROJ); bf16* MIX = (bf16*)(F.ws + WS_MIX);
    const bf16* WUK = (const bf16*)(F.ws + WS_WUK) + (size_t)layer * 128 * 512;
    LAS unsigned char* lds = F.lds;
    LAS unsigned* hist = (LAS unsigned*)(lds + L_MAIN);
    LAS unsigned* candu = (LAS unsigned*)(lds + L_MAIN);
    LAS u16* candi = (LAS u16*)(lds + L_MAIN + 65536);
    LAS u16* sel = (LAS u16*)(lds + L_SEL);
    LAS unsigned* bm = (LAS unsigned*)(lds + L_BM);
    LAS unsigned* Ssum = (LAS unsigned*)(lds + L_SS);
    LAS unsigned* cnt = (LAS unsigned*)(lds + L_CNT); LAS unsigned* ccnt = (LAS unsigned*)(lds + L_CCNT);
    LAS unsigned* thr1 = (LAS unsigned*)(lds + L_THR1); LAS unsigned* need1 = (LAS unsigned*)(lds + L_NEED1);
    const int brow = b * SEQ, t0 = 16 * j, tok0 = brow + t0;

    __syncthreads();
    for (int rep_ = 0; rep_ < ((DBG_REPM & 1) ? 2 : 1); ++rep_) {
        const int cp = tid & 255, th = tid >> 8, ch = 2 * cp, ts = t0 + 8 * th;
        const bf16* up = PROJ + (size_t)brow * NP + ch; bf16* mp = MIX + (size_t)brow * KO + ch;
        switch (wave & 3) { case 0: pool_filter<2, 8>(up, mp, ts); break; case 1: pool_filter<4, 8>(up, mp, ts); break; case 2: pool_filter<8, 8>(up, mp, ts); break; default: pool_filter<16, 8>(up, mp, ts); break; }
    }
    for (int rep_ = 0; rep_ < ((DBG_REPM & 2) ? 2 : 1); ++rep_) {
    if (rep_) __syncthreads();
    if (tid < 16) { cnt[tid] = 0u; ccnt[tid] = 0u; }
    if (j < 16) {
        for (int i = tid; i < 16 * 256; i += 512) sel[i] = (u16)(i & 255);
        __syncthreads();
        if (tid < 16) cnt[tid] = (unsigned)(t0 + tid + 1);
        __syncthreads();
    } else {
        const int n = lane & 15, g = lane >> 4, q = n, tq = t0 + q, hq = 2 * n + (g & 1);
        const bf16* qrow = PROJ + (size_t)(tok0 + q) * NP;
        bf16x8 Bq[8][2]; float wq[8];
#pragma unroll
        for (int h = 0; h < 8; ++h) { wq[h] = bf2f(qrow[COL_IW + h]);
#pragma unroll
            for (int s = 0; s < 2; ++s) Bq[h][s] = *(const bf16x8*)(qrow + COL_IQ + 64 * h + 32 * s + 8 * g); }
        bf16x8 Qh[2], Ql[2];
#pragma unroll
        for (int s = 0; s < 2; ++s) { float a[8];
#pragma unroll
            for (int e = 0; e < 8; ++e) { a[e] = 0.f;
#pragma unroll
                for (int h = 0; h < 8; ++h) a[e] += wq[h] * bf2f((u16)Bq[h][s][e]); }
            union { bf16x8 v; unsigned u[4]; } hi, lo;
#pragma unroll
            for (int e = 0; e < 4; ++e) { hi.u[e] = cvtpk(a[2 * e], a[2 * e + 1]);
                lo.u[e] = cvtpk(a[2 * e] - bf2f((u16)(hi.u[e] & 0xffff)), a[2 * e + 1] - bf2f((u16)(hi.u[e] >> 16))); }
            Qh[s] = hi.v; Ql[s] = lo.v; }
        const int ktmax = (t0 + 15) >> 5;
        { f32x4 z = (f32x4){0.f, 0.f, 0.f, 0.f}; for (int i = tid; i < 8192; i += 512) *(LAS f32x4*)(hist + 4 * i) = z; }
        __syncthreads();
        const bf16* kbase = PROJ + (size_t)(brow + n) * NP + COL_IK + 8 * g;
#pragma unroll 1
        for (int pass = 0; pass < 2; ++pass) {
            const unsigned b1 = pass ? thr1[q] : 0u;
            bf16x8 An[2][2];
            { const bf16* krow = kbase + (size_t)(32 * (wave <= ktmax ? wave : 0)) * NP;
#pragma unroll
                for (int kb = 0; kb < 2; ++kb)
#pragma unroll
                    for (int s = 0; s < 2; ++s) An[kb][s] = *(const bf16x8*)(krow + (size_t)(16 * kb) * NP + 32 * s); }
#pragma unroll 1
            for (int kt = wave; kt <= ktmax; kt += 8) {
                bf16x8 A[2][2];
#pragma unroll
                for (int kb = 0; kb < 2; ++kb)
#pragma unroll
                    for (int s = 0; s < 2; ++s) A[kb][s] = An[kb][s];
                { const bf16* krow = kbase + (size_t)(32 * (kt + 8 <= ktmax ? kt + 8 : kt)) * NP;
#pragma unroll
                    for (int kb = 0; kb < 2; ++kb)
#pragma unroll
                        for (int s = 0; s < 2; ++s) An[kb][s] = *(const bf16x8*)(krow + (size_t)(16 * kb) * NP + 32 * s); }
                f32x4 L[2];
#pragma unroll
                for (int kb = 0; kb < 2; ++kb) { L[kb] = (f32x4){0.f, 0.f, 0.f, 0.f};
#pragma unroll
                    for (int s = 0; s < 2; ++s) { L[kb] = __builtin_amdgcn_mfma_f32_16x16x32_bf16(A[kb][s], Qh[s], L[kb], 0, 0, 0); L[kb] = __builtin_amdgcn_mfma_f32_16x16x32_bf16(A[kb][s], Ql[s], L[kb], 0, 0, 0); } }
                float sc[8];
#pragma unroll
                for (int r = 0; r < 8; ++r) sc[r] = L[r >> 2][r & 3];
                f32x4 C0, C1;
#define MIX_HEAD_MFMA(h) do { C0 = (f32x4){0.f, 0.f, 0.f, 0.f}; C1 = (f32x4){0.f, 0.f, 0.f, 0.f}; \
                    C0 = __builtin_amdgcn_mfma_f32_16x16x32_bf16(A[0][0], Bq[h][0], C0, 0, 0, 0); C1 = __builtin_amdgcn_mfma_f32_16x16x32_bf16(A[1][0], Bq[h][0], C1, 0, 0, 0); \
                    C0 = __builtin_amdgcn_mfma_f32_16x16x32_bf16(A[0][1], Bq[h][1], C0, 0, 0, 0); C1 = __builtin_amdgcn_mfma_f32_16x16x32_bf16(A[1][1], Bq[h][1], C1, 0, 0, 0); } while (0)
#define MIX_HEAD_FMA(h) asm volatile("s_nop 6\n\tv_fma_f32 %0, %8, |%9|, %0\n\tv_fma_f32 %1, %8, |%10|, %1\n\tv_fma_f32 %2, %8, |%11|, %2\n\tv_fma_f32 %3, %8, |%12|, %3\n\t" \
                                     "v_fma_f32 %4, %8, |%13|, %4\n\tv_fma_f32 %5, %8, |%14|, %5\n\tv_fma_f32 %6, %8, |%15|, %6\n\tv_fma_f32 %7, %8, |%16|, %7" \
                                     : "+v"(sc[0]), "+v"(sc[1]), "+v"(sc[2]), "+v"(sc[3]), "+v"(sc[4]), "+v"(sc[5]), "+v"(sc[6]), "+v"(sc[7]) \
                                     : "v"(wq[h]), "v"(C0[0]), "v"(C0[1]), "v"(C0[2]), "v"(C0[3]), "v"(C1[0]), "v"(C1[1]), "v"(C1[2]), "v"(C1[3]))
#pragma unroll
                for (int h = 0; h < 8; ++h) { MIX_HEAD_MFMA(h); MIX_HEAD_FMA(h); }
#undef MIX_HEAD_MFMA
#undef MIX_HEAD_FMA
                const int key0 = 32 * kt + 4 * g;
                if (kt == ktmax) {
#pragma unroll
                    for (int r = 0; r < 8; ++r) if (key0 + 16 * (r >> 2) + (r & 3) > tq) sc[r] = -__builtin_inff();
                }
                unsigned u[8];
#pragma unroll
                for (int r = 0; r < 8; ++r) u[r] = fkey(sc[r]);
                if (pass == 0) {
#pragma unroll
                    for (int r = 0; r < 8; ++r) { const unsigned bin = u[r] >> 21; __hip_atomic_fetch_add(hist + (bin >> 1) * 32 + hq, 1u << ((bin & 1u) * 16u), __ATOMIC_RELAXED, __HIP_MEMORY_SCOPE_WORKGROUP); }
                } else {
                    unsigned selbits = 0u, cmask = 0u;
#pragma unroll
                    for (int r = 0; r < 8; ++r) { const unsigned bin = u[r] >> 21; if (bin > b1) selbits |= 1u << (4 * g + (r & 3) + 16 * (r >> 2)); else if (bin == b1) cmask |= 1u << r; }
                    selbits |= (unsigned)__shfl_xor((int)selbits, 16); selbits |= (unsigned)__shfl_xor((int)selbits, 32);
                    if (g == 0) bm[q * 128 + kt] = selbits;
                    if (cmask) {
                        unsigned slot = __hip_atomic_fetch_add(ccnt + q, (unsigned)__builtin_popcount(cmask), __ATOMIC_RELAXED, __HIP_MEMORY_SCOPE_WORKGROUP);
#pragma unroll
                        for (int r = 0; r < 8; ++r) if (cmask & (1u << r)) { if (slot < (unsigned)CCAP) { candu[q * CCAP + slot] = u[r]; candi[q * CCAP + slot] = (u16)(key0 + 16 * (r >> 2) + (r & 3)); } ++slot; }
                    }
                }
            }
            __syncthreads();
            if (pass == 0) scan_hist(hist, Ssum, thr1, need1, tid);
        }
        {
#pragma unroll 1
            for (int qi = 0; qi < 2; ++qi) {
                const int q2 = 2 * wave + qi;
                int nc = __builtin_amdgcn_readfirstlane((int)ccnt[q2]); nc = nc < CCAP ? nc : CCAP;
                unsigned need = (unsigned)__builtin_amdgcn_readfirstlane((int)need1[q2]);
                const bool big = nc > 256;
                unsigned cu[16];
#pragma unroll
                for (int k = 0; k < 4; ++k) { const int i = lane + 64 * k; cu[k] = i < nc ? (candu[q2 * CCAP + i] & 0x1fffffu) : 0u; }
#pragma unroll
                for (int k = 4; k < 16; ++k) { const int i = lane + 64 * k; cu[k] = (big && i < nc) ? (candu[q2 * CCAP + i] & 0x1fffffu) : 0u; }
                unsigned prefix = 0u;
#pragma unroll 1
                for (int bit = 20; bit >= 0; --bit) {
                    const unsigned t = prefix | (1u << bit); unsigned c = 0u;
#pragma unroll
                    for (int k = 0; k < 4; ++k) c += (unsigned)__builtin_popcountll(__ballot(cu[k] >= t));
                    if (big) {
#pragma unroll
                        for (int k = 4; k < 16; ++k) c += (unsigned)__builtin_popcountll(__ballot(cu[k] >= t)); }
                    if (c >= need) prefix = t;
                }
                { unsigned c = 0u;
#pragma unroll
                    for (int k = 0; k < 16; ++k) c += (unsigned)__builtin_popcountll(__ballot(cu[k] > prefix));
                    need -= c < need ? c : need; }
                unsigned eqbits = 0u;
#pragma unroll
                for (int k = 0; k < 16; ++k) {
                    if (cu[k] == prefix && lane + 64 * k < nc) eqbits |= 1u << k;
                    if (cu[k] > prefix) { const unsigned id = candi[q2 * CCAP + lane + 64 * k]; __hip_atomic_fetch_or(bm + q2 * 128 + (id >> 5), 1u << (id & 31u), __ATOMIC_RELAXED, __HIP_MEMORY_SCOPE_WORKGROUP); }
                }
#pragma unroll 1
                for (unsigned it = 0; it < need; ++it) {
                    unsigned mymin = 0xffffu;
#pragma unroll
                    for (int k = 0; k < 16; ++k) if (eqbits & (1u << k)) { const unsigned id = candi[q2 * CCAP + lane + 64 * k]; mymin = id < mymin ? id : mymin; }
                    unsigned wmin = mymin;
#pragma unroll
                    for (int o = 1; o < 64; o <<= 1) { const unsigned t = (unsigned)__shfl_xor((int)wmin, o); wmin = t < wmin ? t : wmin; }
                    if (wmin == 0xffffu) break;
                    if (lane == 0) __hip_atomic_fetch_or(bm + q2 * 128 + (wmin >> 5), 1u << (wmin & 31u), __ATOMIC_RELAXED, __HIP_MEMORY_SCOPE_WORKGROUP);
#pragma unroll
                    for (int k = 0; k < 16; ++k) if ((eqbits & (1u << k)) && candi[q2 * CCAP + lane + 64 * k] == wmin) eqbits &= ~(1u << k);
                }
                asm volatile("s_waitcnt lgkmcnt(0)" ::: "memory");
                {
                    const int nw = ktmax + 1;
                    unsigned w0 = 2 * lane < nw ? bm[q2 * 128 + 2 * lane] : 0u, w1 = 2 * lane + 1 < nw ? bm[q2 * 128 + 2 * lane + 1] : 0u;
                    const unsigned c = (unsigned)(__builtin_popcount(w0) + __builtin_popcount(w1));
                    unsigned inc = c;
#pragma unroll
                    for (int d = 1; d < 64; d <<= 1) { const unsigned t = (unsigned)__shfl_up((int)inc, d); inc += (lane >= d) ? t : 0u; }
                    unsigned pos = inc - c;
                    while (w0) { const int bpos = __builtin_ctz(w0); w0 &= w0 - 1u; if (pos < 256u) sel[q2 * 256 + pos] = (u16)(64 * lane + bpos); ++pos; }
                    while (w1) { const int bpos = __builtin_ctz(w1); w1 &= w1 - 1u; if (pos < 256u) sel[q2 * 256 + pos] = (u16)(64 * lane + 32 + bpos); ++pos; }
                    const unsigned total = (unsigned)__builtin_amdgcn_readlane((int)inc, 63);
                    if (lane == 0) cnt[q2] = total < 256u ? total : 256u;
                }
            }
        }
        __syncthreads();
    }
    }
    LAS unsigned char* QL = lds + L_MAIN + 65536;
    const LAS float* gtab = (const LAS float*)(lds + L_G);
    {
        const int h = wave, n = lane & 15, g = lane >> 4;
        const bf16* qp = PROJ + (size_t)(tok0 + n) * NP + COL_Q + 64 * h + 8 * g;
        const bf16x8 q0 = *(const bf16x8*)qp, q1 = *(const bf16x8*)(qp + 32);
#pragma unroll
        for (int cb = 0; cb < 8; ++cb) {
            const bf16* wp = WUK + (size_t)(16 * cb + n) * 512 + 64 * h + 8 * g;
            f32x4 acc = (f32x4){0.f, 0.f, 0.f, 0.f};
            acc = __builtin_amdgcn_mfma_f32_16x16x32_bf16(*(const bf16x8*)wp, q0, acc, 0, 0, 0);
            acc = __builtin_amdgcn_mfma_f32_16x16x32_bf16(*(const bf16x8*)(wp + 32), q1, acc, 0, 0, 0);
            const f32x4 gg = *(const LAS f32x4*)(gtab + 16 * cb + 4 * g);
            u32x2 o; o.x = cvtpk(acc[0] * gg[0] * 1.44269504f, acc[1] * gg[1] * 1.44269504f); o.y = cvtpk(acc[2] * gg[2] * 1.44269504f, acc[3] * gg[3] * 1.44269504f);
            *(LAS u32x2*)(QL + n * 2048 + h * 256 + (16 * cb + 4 * g) * 2) = o;
        }
    }
    __syncthreads();
    for (int rep_ = 0; rep_ < ((DBG_REPM & 4) ? 2 : 1); ++rep_) {
        const int n = lane & 15, g = lane >> 4, hh = n & 7, m = n, rr = lane >> 4, c16 = lane & 15;
        const LAS float* lut = (const LAS float*)(lds + L_LUT);
        LAS unsigned char* T = lds + L_MAIN + wave * 8192;
        const unsigned tbase = (unsigned)(size_t)T;
        const int kap0 = 8 * (m >> 2) + (m & 3), kap1 = kap0 + 4;
        unsigned tra[8][2];
#pragma unroll
        for (int cb = 0; cb < 8; ++cb)
#pragma unroll
            for (int t = 0; t < 2; ++t) tra[cb][t] = tbase + off_b((unsigned)(8 * g + 4 * t + ((lane & 15) >> 2)), (unsigned)(2 * cb + ((lane & 3) >> 1))) + 8u * (lane & 1);
        unsigned rda[2][4], wrg[8];
#pragma unroll
        for (int s = 0; s < 4; ++s) { rda[0][s] = off_b((unsigned)kap0, (unsigned)(4 * s + g)); rda[1][s] = off_b((unsigned)kap1, (unsigned)(4 * s + g)); }
#pragma unroll
        for (int i = 0; i < 8; ++i) wrg[i] = off_b((unsigned)(4 * i + rr), (unsigned)c16);
        const float b31 = lut[128 * 8 + hh];
        const bool dmy = ((DBG_REPM & 4) != 0) && rep_ == 0; (void)dmy;
#pragma unroll 1
        for (int qi = 0; qi < 2; ++qi) {
            const int q = wave * 2 + qi, tq = t0 + q, nv = __builtin_amdgcn_readfirstlane((int)cnt[q]), nch = (nv + 31) >> 5;
            const LAS u16* selq = sel + q * 256;
            bf16x8 Bq[4];
#pragma unroll
            for (int s = 0; s < 4; ++s) { Bq[s] = *(const LAS bf16x8*)(QL + q * 2048 + hh * 256 + (32 * s + 8 * g) * 2); if (n >= 8) Bq[s] = (bf16x8){0, 0, 0, 0, 0, 0, 0, 0}; }
            float mref = 0.f, lrun = 0.f; f32x4 O[8];
#pragma unroll
            for (int cb = 0; cb < 8; ++cb) O[cb] = (f32x4){0.f, 0.f, 0.f, 0.f};
            bf16x8 xa[8], xb[8];
#define MIX_GATHER(CH, X) do { const u16x8 id8_ = *(const LAS u16x8*)(selq + 32 * (CH) + 8 * rr); \
                _Pragma("unroll") for (int i = 0; i < 8; ++i) { const int ix_ = 32 * (CH) + 8 * rr + i < nv ? (int)id8_[i] : 0; \
                    X[i] = *(const bf16x8*)(PROJ + (size_t)(brow + ix_) * NP + COL_C + 8 * c16); } } while (0)
#define MIX_CHUNK(CH, X, NEXT_GATHER) do { \
                const int last_ = 32 * (CH) + 31 < nv ? 32 * (CH) + 31 : nv - 1; \
                const bool far_ = __builtin_amdgcn_readfirstlane(tq - (int)selq[last_]) >= 128; \
                _Pragma("unroll") for (int i = 0; i < 8; ++i) *(LAS bf16x8*)(T + wrg[i]) = X[i]; \
                NEXT_GATHER; \
                asm volatile("s_waitcnt lgkmcnt(0)" ::: "memory"); \
                bf16x8 A0[4], A1[4]; \
                _Pragma("unroll") for (int s = 0; s < 4; ++s) { A0[s] = *(const LAS bf16x8*)(T + rda[0][s]); A1[s] = *(const LAS bf16x8*)(T + rda[1][s]); } \
                f32x4 S0 = (f32x4){0.f, 0.f, 0.f, 0.f}, S1 = S0, S2 = S0, S3 = S0; \
                S0 = __builtin_amdgcn_mfma_f32_16x16x32_bf16(A0[0], Bq[0], S0, 0, 0, 0); S1 = __builtin_amdgcn_mfma_f32_16x16x32_bf16(A1[0], Bq[0], S1, 0, 0, 0); \
                S2 = __builtin_amdgcn_mfma_f32_16x16x32_bf16(A0[1], Bq[1], S2, 0, 0, 0); S3 = __builtin_amdgcn_mfma_f32_16x16x32_bf16(A1[1], Bq[1], S3, 0, 0, 0); \
                S0 = __builtin_amdgcn_mfma_f32_16x16x32_bf16(A0[2], Bq[2], S0, 0, 0, 0); S1 = __builtin_amdgcn_mfma_f32_16x16x32_bf16(A1[2], Bq[2], S1, 0, 0, 0); \
                S2 = __builtin_amdgcn_mfma_f32_16x16x32_bf16(A0[3], Bq[3], S2, 0, 0, 0); S3 = __builtin_amdgcn_mfma_f32_16x16x32_bf16(A1[3], Bq[3], S3, 0, 0, 0); \
                float lg[8];     \
                _Pragma("unroll") for (int jx = 0; jx < 4; ++jx) { lg[jx] = S0[jx] + S2[jx]; lg[4 + jx] = S1[jx] + S3[jx]; } \
                if (far_) { _Pragma("unroll") for (int jx = 0; jx < 8; ++jx) lg[jx] += b31; } \
                else { _Pragma("unroll") for (int jx = 0; jx < 8; ++jx) { const int pj_ = 32 * (CH) + 8 * (jx & 3) + 2 * g + (jx >> 2); \
                        int dist = tq - (int)selq[pj_ < nv ? pj_ : 0]; dist = dist < 0 ? 0 : (dist > 128 ? 128 : dist); lg[jx] += lut[dist * 8 + hh]; } } \
                if (32 * (CH) + 32 > nv) { _Pragma("unroll") for (int jx = 0; jx < 8; ++jx) if (32 * (CH) + 8 * (jx & 3) + 2 * g + (jx >> 2) >= nv) lg[jx] = -1e30f; } \
                if ((CH) == 0) { float cm = fmaxf(fmaxf(fmaxf(lg[0], lg[1]), fmaxf(lg[2], lg[3])), fmaxf(fmaxf(lg[4], lg[5]), fmaxf(lg[6], lg[7]))); \
                    cm = fmaxf(cm, __shfl_xor(cm, 16)); cm = fmaxf(cm, __shfl_xor(cm, 32)); mref = cm; } \
                float pp[8]; \
                _Pragma("unroll") for (int jx = 0; jx < 8; ++jx) { pp[jx] = __builtin_amdgcn_exp2f(__builtin_amdgcn_fmed3f(lg[jx] - mref, -200.f, 100.f)); lrun += pp[jx]; } \
                union { bf16x8 v; unsigned u[4]; } P; \
                P.u[0] = cvtpk(pp[0], pp[1]); P.u[1] = cvtpk(pp[2], pp[3]); P.u[2] = cvtpk(pp[4], pp[5]); P.u[3] = cvtpk(pp[6], pp[7]); \
                u16x4 x0, x1, x2, x3, x4, x5, x6, x7, y0, y1, y2, y3, y4, y5, y6, y7; \
                asm volatile("s_waitcnt lgkmcnt(0)\n\tds_read_b64_tr_b16 %0, %8\n\tds_read_b64_tr_b16 %1, %9\n\tds_read_b64_tr_b16 %2, %10\n\tds_read_b64_tr_b16 %3, %11\n\t" \
                             "ds_read_b64_tr_b16 %4, %12\n\tds_read_b64_tr_b16 %5, %13\n\tds_read_b64_tr_b16 %6, %14\n\tds_read_b64_tr_b16 %7, %15" \
                             : "=&v"(x0), "=&v"(x1), "=&v"(x2), "=&v"(x3), "=&v"(x4), "=&v"(x5), "=&v"(x6), "=&v"(x7) \
                             : "v"(tra[0][0]), "v"(tra[0][1]), "v"(tra[1][0]), "v"(tra[1][1]), "v"(tra[2][0]), "v"(tra[2][1]), "v"(tra[3][0]), "v"(tra[3][1]) : "memory"); \
                asm volatile("ds_read_b64_tr_b16 %0, %8\n\tds_read_b64_tr_b16 %1, %9\n\tds_read_b64_tr_b16 %2, %10\n\tds_read_b64_tr_b16 %3, %11\n\t" \
                             "ds_read_b64_tr_b16 %4, %12\n\tds_read_b64_tr_b16 %5, %13\n\tds_read_b64_tr_b16 %6, %14\n\tds_read_b64_tr_b16 %7, %15\n\ts_waitcnt lgkmcnt(0)" \
                             : "=&v"(y0), "=&v"(y1), "=&v"(y2), "=&v"(y3), "=&v"(y4), "=&v"(y5), "=&v"(y6), "=&v"(y7) \
                             : "v"(tra[4][0]), "v"(tra[4][1]), "v"(tra[5][0]), "v"(tra[5][1]), "v"(tra[6][0]), "v"(tra[6][1]), "v"(tra[7][0]), "v"(tra[7][1]) : "memory"); \
                __builtin_amdgcn_sched_barrier(0);      \
                union { bf16x8 v; u16x4 h[2]; } A_; \
                A_.h[0] = x0; A_.h[1] = x1; O[0] = __builtin_amdgcn_mfma_f32_16x16x32_bf16(A_.v, P.v, O[0], 0, 0, 0); \
                A_.h[0] = x2; A_.h[1] = x3; O[1] = __builtin_amdgcn_mfma_f32_16x16x32_bf16(A_.v, P.v, O[1], 0, 0, 0); \
                A_.h[0] = x4; A_.h[1] = x5; O[2] = __builtin_amdgcn_mfma_f32_16x16x32_bf16(A_.v, P.v, O[2], 0, 0, 0); \
                A_.h[0] = x6; A_.h[1] = x7; O[3] = __builtin_amdgcn_mfma_f32_16x16x32_bf16(A_.v, P.v, O[3], 0, 0, 0); \
                A_.h[0] = y0; A_.h[1] = y1; O[4] = __builtin_amdgcn_mfma_f32_16x16x32_bf16(A_.v, P.v, O[4], 0, 0, 0); \
                A_.h[0] = y2; A_.h[1] = y3; O[5] = __builtin_amdgcn_mfma_f32_16x16x32_bf16(A_.v, P.v, O[5], 0, 0, 0); \
                A_.h[0] = y4; A_.h[1] = y5; O[6] = __builtin_amdgcn_mfma_f32_16x16x32_bf16(A_.v, P.v, O[6], 0, 0, 0); \
                A_.h[0] = y6; A_.h[1] = y7; O[7] = __builtin_amdgcn_mfma_f32_16x16x32_bf16(A_.v, P.v, O[7], 0, 0, 0); } while (0)
            MIX_GATHER(0, xa);
            if (nch > 1) MIX_GATHER(1, xb);
#pragma unroll 1
            for (int ch = 0; ch < nch; ch += 2) {
                MIX_CHUNK(ch, xa, if (ch + 2 < nch) MIX_GATHER(ch + 2, xa));
                if (ch + 1 < nch) MIX_CHUNK(ch + 1, xb, if (ch + 3 < nch) MIX_GATHER(ch + 3, xb));
            }
#undef MIX_CHUNK
            float lt = lrun; lt += __shfl_xor(lt, 16); lt += __shfl_xor(lt, 32);
            const float inv = 1.0f / lt;
            if (n < 8) {
                bf16* op = MIX + (size_t)(tok0 + q) * KO + 512 + n * 128 + 4 * g;
#pragma unroll
                for (int cb = 0; cb < 8; ++cb) { const f32x4 gg = *(const LAS f32x4*)(gtab + 16 * cb + 4 * g);
                    u32x2 o; o.x = cvtpk(O[cb][0] * inv * gg[0], O[cb][1] * inv * gg[1]); o.y = cvtpk(O[cb][2] * inv * gg[2], O[cb][3] * inv * gg[3]);
                    *(u32x2*)(op + 16 * cb) = o; }
            }
        }
    }
}

#undef MIX_GATHER
__device__ __forceinline__ void cnorm_phase(Frame& F) {
    bf16* PROJ = (bf16*)(F.ws + WS_PROJ);
    const int gw = F.vcu * NWAVES + F.wave, NGW = F.G * NWAVES, lane = F.lane;
    for (int r4 = gw; r4 < M / 4; r4 += NGW) {
        bf16* p = PROJ + (size_t)(4 * r4 + (lane >> 4)) * NP + COL_C + 8 * (lane & 15);
        const v4u w = *(const GAS v4u*)p;
        float v[8] = {__builtin_bit_cast(float, w.x << 16), __builtin_bit_cast(float, w.x & 0xffff0000u), __builtin_bit_cast(float, w.y << 16), __builtin_bit_cast(float, w.y & 0xffff0000u),
                      __builtin_bit_cast(float, w.z << 16), __builtin_bit_cast(float, w.z & 0xffff0000u), __builtin_bit_cast(float, w.w << 16), __builtin_bit_cast(float, w.w & 0xffff0000u)};
        float ss = 0.f;
#pragma unroll
        for (int e = 0; e < 8; ++e) ss += v[e] * v[e];
        ss += __shfl_xor(ss, 1); ss += __shfl_xor(ss, 2); ss += __shfl_xor(ss, 4); ss += __shfl_xor(ss, 8);
        const float r = 1.0f / sqrtf(ss * (1.0f / 128.0f) + LN_EPS);
        v4u o; o.x = cvtpk(v[0] * r, v[1] * r); o.y = cvtpk(v[2] * r, v[3] * r); o.z = cvtpk(v[4] * r, v[5] * r); o.w = cvtpk(v[6] * r, v[7] * r);
        *(GAS v4u*)p = o;
    }
}
__device__ __forceinline__ void mix_phase(Frame& F, int layer, const float* rel_bias, const float* kvg) {
    LAS float* lut = (LAS float*)(F.lds + L_LUT); LAS float* gtab = (LAS float*)(F.lds + L_G);
    for (int i = F.tid; i < 129 * 8; i += 512) { const int nd = i >> 3, h = i & 7; int bk;
        if (nd < 16) bk = nd; else { bk = 16 + (int)(logf((float)nd / 16.0f) / logf(8.0f) * 16.0f); bk = bk > 31 ? 31 : bk; }
        lut[i] = rel_bias[bk * 8 + h] * 1.44269504f; }
    if (F.tid < 128) gtab[F.tid] = kvg[F.tid];
    __syncthreads();
#pragma unroll 1
    for (int it = 2 * F.vcu; it < 2048; ++it) { const int p = it >> 1, b = p >> 7, jj = (p + 32 * (p >> 8)) & 127;
        mix_unit(F, layer, b, (it & 1) ? 255 - jj : jj); if (it & 1) it += 2 * F.G - 2; }
    __syncthreads();
}
}

struct Args { const float* in[17]; float* out; unsigned char* ws; int ph_lo, ph_hi; };
static_assert(sizeof(Args) == 17 * 8 + 8 + 8 + 8, "Args has no padding");
#if MK_PER_PHASE
#define GRID_BAR() do { } while (0)
#else
#define GRID_BAR() xcd_barrier(bar)
#endif
#define IN(k) (lo <= (k) && (k) < hi)
#define SEAM(k) do { if (IN((k) + 1)) GRID_BAR(); } while (0)
template <int L>
__device__ __forceinline__ void run_layer(Frame& F, const XcdBarrier& bar, const int lo, const int hi, const float* rel_bias, const float* kvg, const float* ln1g, const float* ln1b, const float* ln2g, const float* ln2b) {
    constexpr int pb = 1 + 8 * L;
    bf16* XN = (bf16*)(F.ws + WS_XN); bf16* PROJ = (bf16*)(F.ws + WS_PROJ); bf16* MIX = (bf16*)(F.ws + WS_MIX); bf16* HB = (bf16*)(F.ws + WS_H);
#ifndef DBG_NO_GEMM
    if (IN(pb + 0)) {
        pg8::Gemm g{XN, (const bf16*)(F.ws + WS_WIN) + (size_t)L * NP * D, M, NP, D}; pg8::StaticOrder S; S.init(M, NP, F.G, (int)blockIdx.x);
        pg8::EpiProj E{PROJ, NP};
        pg8::gemm_phase<pg8::EpiProj, pg8::StaticOrder, PG8_ALIGN, PG8_SP2>(F.lds + L_MAIN, g, S, E);
        SEAM(pb + 0);
    }
#endif
#ifndef DBG_NO_MIX
    if (IN(pb + 1)) { mixp::cnorm_phase(F); SEAM(pb + 1); }
    if (IN(pb + 2)) {
#if (DBG_REP & 2)
        mixp::mix_phase(F, L, rel_bias, kvg); GRID_BAR();
#endif
        mixp::mix_phase(F, L, rel_bias, kvg); SEAM(pb + 2); }
#endif
#ifndef DBG_NO_GEMM
    if (IN(pb + 3)) {
        pg8::Gemm g{MIX, (const bf16*)(F.ws + WS_WO) + (size_t)L * D * KO, M, D, KO}; pg8::StaticOrder S; S.init(M, D, F.G, (int)blockIdx.x);
        pg8::EpiRes E{XN, D, ALPHA};
        pg8::gemm_phase<pg8::EpiRes, pg8::StaticOrder, PG8_ALIGN, PG8_SP2>(F.lds + L_MAIN, g, S, E);
        SEAM(pb + 3);
    }
    if (IN(pb + 4)) { ln_phase(F, ln1g, ln1b, false); SEAM(pb + 4); }
    if (IN(pb + 5)) {
        pg8::Gemm g{XN, (const bf16*)(F.ws + WS_WUP) + (size_t)L * FF * D, M, FF, D}; pg8::StaticOrder S; S.init(M, FF, F.G, (int)blockIdx.x);
        pg8::EpiRelu2 E{HB, FF};
#if (DBG_REP & 4)
        pg8::gemm_phase<pg8::EpiRelu2, pg8::StaticOrder, PG8_ALIGN, PG8_SP2>(F.lds + L_MAIN, g, S, E); GRID_BAR();
#endif
        pg8::gemm_phase<pg8::EpiRelu2, pg8::StaticOrder, PG8_ALIGN, PG8_SP2>(F.lds + L_MAIN, g, S, E);
        SEAM(pb + 6);
    }
    if (IN(pb + 6)) {
        pg8::Gemm g{HB, (const bf16*)(F.ws + WS_WDN) + (size_t)L * D * FF, M, D, FF}; pg8::StaticOrder S; S.init(M, D, F.G, (int)blockIdx.x);
        pg8::EpiRes E{XN, D, ALPHA};
        pg8::gemm_phase<pg8::EpiRes, pg8::StaticOrder, PG8_ALIGN, PG8_SP2>(F.lds + L_MAIN, g, S, E);
        SEAM(pb + 6);
    }
#endif
    if (IN(pb + 7)) { ln_phase(F, ln2g, ln2b, L + 1 == NLAYER); if (L + 1 < NLAYER) SEAM(pb + 7); }
}
__global__ void __launch_bounds__(NWAVES * 64, 2) hymba_fwd(Args args) {
    extern __shared__ __attribute__((aligned(16))) unsigned char lds[];
    Frame F;
    F.lds = (LAS unsigned char*)lds;
    F.tid = threadIdx.x; F.lane = F.tid & 63; F.wave = __builtin_amdgcn_readfirstlane(F.tid >> 6);
    F.G = gridDim.x; { const int bx = blockIdx.x; F.vcu = (F.G % 8 == 0) ? (bx % 8) * (F.G / 8) + bx / 8 : bx; }
    F.out = args.out; F.ws = args.ws;
    volatile LAS unsigned* MISC = (volatile LAS unsigned*)(F.lds + L_MISC);
    if (F.tid < 32) MISC[F.tid] = 0u;
    __syncthreads();
    XcdBarrier bar; bar.bar = (unsigned*)(F.ws + WS_CTL) + CW_BAR; bar.x = 0; bar.st = nullptr;
#if !MK_PER_PHASE
    bar = xcd_barrier_post((unsigned*)(F.ws + WS_CTL) + CW_BAR, MISC + 8);
#endif
    const int lo = args.ph_lo, hi = args.ph_hi;
#ifndef DBG_NO_PRO
    if (IN(0)) {
#if (DBG_REP & 1)
        p0_prologue(F, args.in[0], args.in[1], args.in[2], args.in[4], args.in[5], args.in[6], args.in[8], args.in[9], args.in[10], args.in[13], args.in[14], DBG_PMASK); GRID_BAR();
#endif
        p0_prologue(F, args.in[0], args.in[1], args.in[2], args.in[4], args.in[5], args.in[6], args.in[8], args.in[9], args.in[10], args.in[13], args.in[14]); SEAM(0); }
#endif
    run_layer<0>(F, bar, lo, hi, args.in[3], args.in[7], args.in[11], args.in[12], args.in[15], args.in[16]);
    run_layer<1>(F, bar, lo, hi, args.in[3], args.in[7] + 128, args.in[11] + D, args.in[12] + D, args.in[15] + D, args.in[16] + D);
}
#undef IN
#undef SEAM
#undef GRID_BAR

extern "C" void kernel_launch(void* const* d_in, const int* in_sizes, int n_in, void* d_out, int out_size, void* d_ws, size_t ws_size, hipStream_t stream) {
    static int grid = 0;
    if (grid == 0) {
        if (n_in != 17 || in_sizes[0] != M * D || out_size != M * D || ws_size < WS_END) { fprintf(stderr, "kernel_launch: unexpected shapes (n_in %d, in0 %d, out %d, ws %zu)\n", n_in, n_in > 0 ? in_sizes[0] : -1, out_size, ws_size); grid = -1; return; }
        int dev = 0, cus = 0, per_cu = 0;
        if (hipGetDevice(&dev) != hipSuccess || hipDeviceGetAttribute(&cus, hipDeviceAttributeMultiprocessorCount, dev) != hipSuccess) { grid = -1; return; }
        if (hipFuncSetAttribute((const void*)hymba_fwd, hipFuncAttributeMaxDynamicSharedMemorySize, LDS_BYTES) != hipSuccess) { fprintf(stderr, "kernel_launch: hipFuncSetAttribute failed\n"); grid = -1; return; }
        if (hipOccupancyMaxActiveBlocksPerMultiprocessor(&per_cu, (const void*)hymba_fwd, NWAVES * 64, LDS_BYTES) != hipSuccess || per_cu < 1) { fprintf(stderr, "kernel_launch: occupancy query says %d blocks per CU\n", per_cu); per_cu = 1; }
        (void)hipGetLastError();
        grid = cus;
    }
    if (grid < 0) return;
    (void)hipMemsetAsync((char*)d_ws + WS_CTL, 0, CTL_ZERO_BYTES, stream);
    Args a{};
    for (int i = 0; i < 17; ++i) a.in[i] = (const float*)d_in[i];
    a.out = (float*)d_out; a.ws = (unsigned char*)d_ws;
#if MK_PER_PHASE
    for (int p = 0; p < N_PHASES; ++p) { a.ph_lo = p; a.ph_hi = p + 1; hipLaunchKernelGGL(hymba_fwd, dim3(grid), dim3(NWAVES * 64), LDS_BYTES, stream, a); }
#else
    a.ph_lo = 0; a.ph_hi = N_PHASES;
    hipLaunchKernelGGL(hymba_fwd, dim3(grid), dim3(NWAVES * 64), LDS_BYTES, stream, a);
#endif
    const hipError_t le = hipPeekAtLastError();
    if (le != hipSuccess) fprintf(stderr, "kernel_launch: launch failed: %s\n", hipGetErrorName(le));
}
```
